# Optimizing an MI355X kernel written in HIP

```python
import jax
import jax.numpy as jnp
from jax import lax
import numpy as np

D_MODEL = 1024
BATCH = 8
SEQ = 4096
DEPTH = 4

GRID_W = 64
CTX_LEN = 256
N_MIXERS = 3
N_MOD = 9
D_FF = 2816
HEAD_DIM = 64
N_HEADS = D_MODEL // HEAD_DIM
N_KV_HEADS = 4
GROUP = N_HEADS // N_KV_HEADS
D_KV = N_KV_HEADS * HEAD_DIM
Q_BLOCK = 128
WINDOW = 128
ROPE_THETA = 10000.0
N_FREQ = HEAD_DIM // 4
ATTN_SCALE = HEAD_DIM ** -0.5
RWKV_HEAD = 64
RWKV_HEADS = D_MODEL // RWKV_HEAD
DECAY_LORA = 64
ICLR_LORA = 64
VALUE_LORA = 32
GATE_LORA = 160
NORM_EPS = 1e-6
GN_EPS = 64e-5
L2_EPS = 1e-12
NEG_INF = -1e30
N_RWKV = (DEPTH + 2) // N_MIXERS
N_GLOBAL = (DEPTH + 1) // N_MIXERS
N_LOCAL = DEPTH // N_MIXERS

kernel_name = 'hybrid_rwkv7_gqa_swa_macaron_dit'


def rms_norm(x, g):
    xf = x.astype(jnp.float32)
    y = xf * lax.rsqrt(jnp.mean(xf * xf, axis=-1, keepdims=True) + NORM_EPS)
    return (y * g.astype(jnp.float32)).astype(x.dtype)


def ffn_half(h, shift, scale, gate, g_pre, g_post, w1, w3, w2):
    n = rms_norm(h, g_pre) * (1 + scale) + shift
    y = (jax.nn.silu(n @ w1) * (n @ w3)) @ w2
    return h + 0.5 * gate * rms_norm(y, g_post)


def axial_rope(rows):
    row = jnp.broadcast_to(jnp.arange(rows)[:, None], (rows, GRID_W)).reshape(-1)
    col = jnp.broadcast_to(jnp.arange(GRID_W)[None, :], (rows, GRID_W)).reshape(-1)
    inv_freq = ROPE_THETA ** (-jnp.arange(N_FREQ, dtype=jnp.float32) / N_FREQ)
    ang = jnp.stack([row, col], axis=-1).astype(jnp.float32)[:, :, None] * inv_freq
    return jnp.cos(ang), jnp.sin(ang)


def apply_rope(t, cos, sin):
    shp = t.shape
    tf = t.astype(jnp.float32).reshape(shp[:-1] + (2, 2, N_FREQ))
    t1, t2 = tf[..., 0, :], tf[..., 1, :]
    bshape = (cos.shape[0],) + (1,) * (t.ndim - 3) + (2, N_FREQ)
    c, s = cos.reshape(bshape), sin.reshape(bshape)
    out = jnp.stack([t1 * c - t2 * s, t2 * c + t1 * s], axis=-2)
    return out.reshape(shp).astype(t.dtype)


def gqa_project(n, wq, wk, wv):
    bn, ln, _ = n.shape
    q = (n @ wq).reshape(bn, ln, N_KV_HEADS, GROUP, HEAD_DIM)
    k = (n @ wk).reshape(bn, ln, N_KV_HEADS, HEAD_DIM)
    v = (n @ wv).reshape(bn, ln, N_KV_HEADS, HEAD_DIM)
    return q, k, v


def softmax_attend(q, k, v):
    s = jnp.einsum('bqkgd,bskd->bkgqs', q, k, preferred_element_type=jnp.float32) * ATTN_SCALE
    p = jax.nn.softmax(s, axis=-1).astype(v.dtype)
    return jnp.einsum('bkgqs,bskd->bqkgd', p, v)


def sink_softmax(s, sink_h):
    col = jnp.broadcast_to(sink_h[None, :, :, None, None], s.shape[:-1] + (1,))
    return jax.nn.softmax(jnp.concatenate([s, col], axis=-1), axis=-1)[..., :-1]


def global_attention(n_lat, n_ctx, wq, wk, wv, wo, gq, gk, cos, sin, with_ctx_out):
    bn, ln, _ = n_lat.shape
    q_l, k_l, v_l = gqa_project(n_lat, wq, wk, wv)
    q_c, k_c, v_c = gqa_project(n_ctx, wq, wk, wv)
    q_l = apply_rope(rms_norm(q_l, gq), cos, sin)
    k_l = apply_rope(rms_norm(k_l, gk), cos, sin)
    q_c, k_c = rms_norm(q_c, gq), rms_norm(k_c, gk)
    k_all = jnp.concatenate([k_l, k_c], axis=1)
    v_all = jnp.concatenate([v_l, v_c], axis=1)
    nb = ln // Q_BLOCK
    qb = jnp.moveaxis(q_l.reshape(bn, nb, Q_BLOCK, N_KV_HEADS, GROUP, HEAD_DIM), 1, 0)
    o_l = lax.map(lambda qblk: softmax_attend(qblk, k_all, v_all), qb)
    y_lat = jnp.moveaxis(o_l, 0, 1).reshape(bn, ln, D_MODEL) @ wo
    y_ctx = None
    if with_ctx_out:
        y_ctx = softmax_attend(q_c, k_c, v_c).reshape(n_ctx.shape[0], n_ctx.shape[1], D_MODEL) @ wo
    return y_lat, y_ctx


def window_attention(n_lat, n_ctx, wq, wk, wv, wo, sink, cos, sin, with_ctx_out):
    bn, ln, _ = n_lat.shape
    q_l, k_l, v_l = gqa_project(n_lat, wq, wk, wv)
    q_c, k_c, v_c = gqa_project(n_ctx, wq, wk, wv)
    q_l, k_l = apply_rope(q_l, cos, sin), apply_rope(k_l, cos, sin)
    sink_h = sink.reshape(N_KV_HEADS, GROUP).astype(jnp.float32)
    nb = ln // Q_BLOCK

    def band(t):
        tp = jnp.pad(t.reshape(bn, nb, Q_BLOCK, N_KV_HEADS, HEAD_DIM), ((0, 0), (1, 1), (0, 0), (0, 0), (0, 0)))
        return jnp.moveaxis(jnp.concatenate([tp[:, :-2], tp[:, 1:-1], tp[:, 2:]], axis=2), 1, 0)

    qb = jnp.moveaxis(q_l.reshape(bn, nb, Q_BLOCK, N_KV_HEADS, GROUP, HEAD_DIM), 1, 0)
    kb, vb = band(k_l), band(v_l)
    blk = jnp.arange(nb)
    q_pos = blk[:, None] * Q_BLOCK + jnp.arange(Q_BLOCK)[None, :]
    k_pos = (blk[:, None] - 1) * Q_BLOCK + jnp.arange(3 * Q_BLOCK)[None, :]
    rel = k_pos[:, None, :] - q_pos[:, :, None]
    mask = (jnp.abs(rel) <= WINDOW) & (k_pos[:, None, :] >= 0) & (k_pos[:, None, :] < ln)

    def attend(args):
        qblk, kblk, vblk, m = args
        s_loc = jnp.einsum('bqkgd,bskd->bkgqs', qblk, kblk, preferred_element_type=jnp.float32) * ATTN_SCALE
        s_loc = jnp.where(m, s_loc, NEG_INF)
        s_ctx = jnp.einsum('bqkgd,bskd->bkgqs', qblk, k_c, preferred_element_type=jnp.float32) * ATTN_SCALE
        p = sink_softmax(jnp.concatenate([s_loc, s_ctx], axis=-1), sink_h).astype(vblk.dtype)
        n_loc = kblk.shape[1]
        return (jnp.einsum('bkgqs,bskd->bqkgd', p[..., :n_loc], vblk)
                + jnp.einsum('bkgqs,bskd->bqkgd', p[..., n_loc:], v_c))

    o_l = lax.map(attend, (qb, kb, vb, mask))
    y_lat = jnp.moveaxis(o_l, 0, 1).reshape(bn, ln, D_MODEL) @ wo
    y_ctx = None
    if with_ctx_out:
        s = jnp.einsum('bqkgd,bskd->bkgqs', q_c, k_c, preferred_element_type=jnp.float32) * ATTN_SCALE
        p = sink_softmax(s, sink_h).astype(v_c.dtype)
        o_c = jnp.einsum('bkgqs,bskd->bqkgd', p, v_c)
        y_ctx = o_c.reshape(n_ctx.shape[0], n_ctx.shape[1], D_MODEL) @ wo
    return y_lat, y_ctx


def to_heads(t):
    return t.reshape(t.shape[0], t.shape[1], RWKV_HEADS, RWKV_HEAD)


def centred_shift(x):
    xp = jnp.pad(x, ((0, 0), (1, 1), (0, 0)))
    return 0.5 * (xp[:, :-2] + xp[:, 2:]) - x


def rwkv_features(n, mu, wr, wk, wv, k_k, vres):
    xx = centred_shift(n)
    xr, xw, xk, xv, xa, xg = (n + xx * mu[m] for m in range(6))
    r = xr @ wr
    k = xk @ wk
    v = xv @ wv
    if vres is not None:
        v_first, v0, v1, v2 = vres
        v = v + (v_first - v) * jax.nn.sigmoid(v0 + (xv @ v1) @ v2)
    kk = to_heads(k * k_k).astype(jnp.float32)
    kk = kk / jnp.maximum(jnp.sqrt(jnp.sum(kk * kk, axis=-1, keepdims=True)), L2_EPS)
    return {'r': r, 'k': k, 'v': v, 'kk': kk, 'xw': xw, 'xa': xa, 'xg': xg}


def rwkv_direction(f, k_a, w0, w1, w2, a0, a1, a2, g1, g2):
    w = -jax.nn.softplus(-(w0 + jnp.tanh(f['xw'] @ w1) @ w2)) - 0.5
    a = jax.nn.sigmoid(a0 + (f['xa'] @ a1) @ a2)
    k = f['k'] * (1 + (a - 1) * k_a)
    g = jax.nn.sigmoid(f['xg'] @ g1) @ g2
    a_h = to_heads(a).astype(jnp.float32)
    return {'r': to_heads(f['r']).astype(jnp.float32),
            'decay': jnp.exp(-jnp.exp(to_heads(w).astype(jnp.float32))),
            'k': to_heads(k).astype(jnp.float32),
            'v': to_heads(f['v']).astype(jnp.float32),
            'a': -f['kk'], 'b': f['kk'] * a_h, 'g': g}


def rwkv_scan(state0, dd, reverse):
    def step(s, inp):
        r_t, w_t, k_t, v_t, a_t, b_t = inp
        sa = jnp.einsum('bhvk,bhk->bhv', s, a_t)
        s = s * w_t[:, :, None, :] + sa[..., None] * b_t[:, :, None, :] + v_t[..., None] * k_t[:, :, None, :]
        return s, jnp.einsum('bhvk,bhk->bhv', s, r_t)
    xs = tuple(jnp.moveaxis(dd[nm], 1, 0) for nm in ('r', 'decay', 'k', 'v', 'a', 'b'))
    s_fin, ys = lax.scan(step, state0, xs, reverse=reverse)
    return s_fin, jnp.moveaxis(ys, 0, 1)


def rwkv_readout(y, dd, r_k, ln_w, ln_b):
    mu = jnp.mean(y, axis=-1, keepdims=True)
    var = jnp.mean(jnp.square(y - mu), axis=-1, keepdims=True)
    flat = y.shape[:2] + (D_MODEL,)
    yn = ((y - mu) * lax.rsqrt(var + GN_EPS)).reshape(flat) * ln_w.astype(jnp.float32) + ln_b.astype(jnp.float32)
    bonus = (jnp.sum(dd['r'] * dd['k'] * r_k.astype(jnp.float32), axis=-1, keepdims=True) * dd['v']).reshape(flat)
    return (yn + bonus) * dd['g'].astype(jnp.float32)


def rwkv_mixer(n_lat, n_ctx, p, vres_lat, vres_ctx, with_ctx_out):
    f_lat = rwkv_features(n_lat, p['mu'], p['wr'], p['wk'], p['wv'], p['k_k'], vres_lat)
    f_ctx = rwkv_features(n_ctx, p['mu'], p['wr'], p['wk'], p['wv'], p['k_k'], vres_ctx)
    s0 = jnp.zeros((n_lat.shape[0], RWKV_HEADS, RWKV_HEAD, RWKV_HEAD), jnp.float32)
    o_lat, o_ctx = [], []
    for d in range(2):
        dp = [p[nm][d] for nm in ('w0', 'w1', 'w2', 'a0', 'a1', 'a2', 'g1', 'g2')]
        d_lat = rwkv_direction(f_lat, p['k_a'], *dp)
        d_ctx = rwkv_direction(f_ctx, p['k_a'], *dp)
        s_ctx, y_ctx = rwkv_scan(s0, d_ctx, d == 1)
        _, y_lat = rwkv_scan(s_ctx, d_lat, d == 1)
        o_lat.append(rwkv_readout(y_lat, d_lat, p['r_k'], p['ln_w'][d], p['ln_b'][d]))
        if with_ctx_out:
            o_ctx.append(rwkv_readout(y_ctx, d_ctx, p['r_k'], p['ln_w'][d], p['ln_b'][d]))
    y_lat = (o_lat[0] + o_lat[1]).astype(n_lat.dtype) @ p['wo']
    y_ctx = (o_ctx[0] + o_ctx[1]).astype(n_ctx.dtype) @ p['wo'] if with_ctx_out else None
    return y_lat, y_ctx, f_lat['v'], f_ctx['v']


def setup_inputs(seed: int = 0) -> dict:
    key = jax.random.key(seed)
    ks = iter(jax.random.split(key, 64))

    def nrm(shape, scale=1.0):
        return scale * jax.random.normal(next(ks), shape, jnp.float32)

    d, f = D_MODEL, D_FF
    decay_base = jnp.linspace(-6.5, -1.5, d, dtype=jnp.float32)
    return {
        'x': nrm((BATCH, SEQ, d)),
        'c': nrm((BATCH, d)),
        'ctx': nrm((BATCH, CTX_LEN, d)),
        'c_ctx': nrm((d,)),
        'mod_w': nrm((DEPTH, d, N_MOD * d), 0.5 * d ** -0.5),
        'mod_b': nrm((DEPTH, N_MOD * d), 0.02),
        'norm_g': 1.0 + nrm((DEPTH, 6, d), 0.05),
        'ffn_w1': nrm((DEPTH, 2, d, f), d ** -0.5),
        'ffn_w3': nrm((DEPTH, 2, d, f), d ** -0.5),
        'ffn_w2': nrm((DEPTH, 2, f, d), f ** -0.5),
        'rwkv_mu': jax.random.uniform(next(ks), (N_RWKV, 6, d), jnp.float32),
        'rwkv_wr': nrm((N_RWKV, d, d), d ** -0.5),
        'rwkv_wk': nrm((N_RWKV, d, d), d ** -0.5),
        'rwkv_wv': nrm((N_RWKV, d, d), d ** -0.5),
        'rwkv_wo': nrm((N_RWKV, d, d), d ** -0.5),
        'rwkv_k_k': 0.85 + nrm((N_RWKV, d), 0.05),
        'rwkv_k_a': 1.0 + nrm((N_RWKV, d), 0.05),
        'rwkv_r_k': nrm((N_RWKV, RWKV_HEADS, RWKV_HEAD), 0.1),
        'rwkv_w0': decay_base + nrm((N_RWKV, 2, d), 0.1),
        'rwkv_w1': nrm((N_RWKV, 2, d, DECAY_LORA), 0.1 * d ** -0.5),
        'rwkv_w2': nrm((N_RWKV, 2, DECAY_LORA, d), 0.1 * DECAY_LORA ** -0.5),
        'rwkv_a0': nrm((N_RWKV, 2, d), 0.1),
        'rwkv_a1': nrm((N_RWKV, 2, d, ICLR_LORA), 0.1 * d ** -0.5),
        'rwkv_a2': nrm((N_RWKV, 2, ICLR_LORA, d), 0.1 * ICLR_LORA ** -0.5),
        'rwkv_g1': nrm((N_RWKV, 2, d, GATE_LORA), d ** -0.5),
        'rwkv_g2': nrm((N_RWKV, 2, GATE_LORA, d), GATE_LORA ** -0.5),
        'rwkv_ln_w': 1.0 + nrm((N_RWKV, 2, d), 0.05),
        'rwkv_ln_b': nrm((N_RWKV, 2, d), 0.02),
        'rwkv_v0': 1.0 + nrm((N_RWKV - 1, d), 0.1),
        'rwkv_v1': nrm((N_RWKV - 1, d, VALUE_LORA), 0.1 * d ** -0.5),
        'rwkv_v2': nrm((N_RWKV - 1, VALUE_LORA, d), 0.1 * VALUE_LORA ** -0.5),
        'gattn_wq': nrm((N_GLOBAL, d, N_HEADS * HEAD_DIM), d ** -0.5),
        'gattn_wk': nrm((N_GLOBAL, d, D_KV), d ** -0.5),
        'gattn_wv': nrm((N_GLOBAL, d, D_KV), d ** -0.5),
        'gattn_wo': nrm((N_GLOBAL, N_HEADS * HEAD_DIM, d), (N_HEADS * HEAD_DIM) ** -0.5),
        'gattn_q_norm': 1.0 + nrm((N_GLOBAL, HEAD_DIM), 0.05),
        'gattn_k_norm': 1.0 + nrm((N_GLOBAL, HEAD_DIM), 0.05),
        'wattn_wq': nrm((N_LOCAL, d, N_HEADS * HEAD_DIM), d ** -0.5),
        'wattn_wk': nrm((N_LOCAL, d, D_KV), d ** -0.5),
        'wattn_wv': nrm((N_LOCAL, d, D_KV), d ** -0.5),
        'wattn_wo': nrm((N_LOCAL, N_HEADS * HEAD_DIM, d), (N_HEADS * HEAD_DIM) ** -0.5),
        'wattn_sink': nrm((N_LOCAL, N_HEADS), 0.5),
    }


def reference(x, c, ctx, c_ctx, mod_w, mod_b, norm_g, ffn_w1, ffn_w3, ffn_w2,
              rwkv_mu, rwkv_wr, rwkv_wk, rwkv_wv, rwkv_wo, rwkv_k_k, rwkv_k_a, rwkv_r_k,
              rwkv_w0, rwkv_w1, rwkv_w2, rwkv_a0, rwkv_a1, rwkv_a2, rwkv_g1, rwkv_g2,
              rwkv_ln_w, rwkv_ln_b, rwkv_v0, rwkv_v1, rwkv_v2,
              gattn_wq, gattn_wk, gattn_wv, gattn_wo, gattn_q_norm, gattn_k_norm,
              wattn_wq, wattn_wk, wattn_wv, wattn_wo, wattn_sink):
    rows = x.shape[1] // GRID_W
    cos, sin = axial_rope(rows)
    v_first_lat, v_first_ctx = None, None
    for i in range(DEPTH):
        last = i == DEPTH - 1
        kind, j = i % N_MIXERS, i // N_MIXERS
        g = norm_g[i]
        ml = (jax.nn.silu(c) @ mod_w[i] + mod_b[i]).reshape(-1, N_MOD, 1, D_MODEL)
        ml = [ml[:, m] for m in range(N_MOD)]
        mc = (jax.nn.silu(c_ctx) @ mod_w[i] + mod_b[i]).reshape(N_MOD, D_MODEL)
        x = ffn_half(x, ml[0], ml[1], ml[2], g[0], g[1], ffn_w1[i, 0], ffn_w3[i, 0], ffn_w2[i, 0])
        ctx = ffn_half(ctx, mc[0], mc[1], mc[2], g[0], g[1], ffn_w1[i, 0], ffn_w3[i, 0], ffn_w2[i, 0])
        n_lat = rms_norm(x, g[2]) * (1 + ml[4]) + ml[3]
        n_ctx = rms_norm(ctx, g[2]) * (1 + mc[4]) + mc[3]
        if kind == 0:
            p = {'mu': rwkv_mu[j], 'wr': rwkv_wr[j], 'wk': rwkv_wk[j], 'wv': rwkv_wv[j], 'wo': rwkv_wo[j],
                 'k_k': rwkv_k_k[j], 'k_a': rwkv_k_a[j], 'r_k': rwkv_r_k[j],
                 'w0': rwkv_w0[j], 'w1': rwkv_w1[j], 'w2': rwkv_w2[j],
                 'a0': rwkv_a0[j], 'a1': rwkv_a1[j], 'a2': rwkv_a2[j],
                 'g1': rwkv_g1[j], 'g2': rwkv_g2[j], 'ln_w': rwkv_ln_w[j], 'ln_b': rwkv_ln_b[j]}
            vres_lat, vres_ctx = None, None
            if j > 0:
                vres_lat = (v_first_lat, rwkv_v0[j - 1], rwkv_v1[j - 1], rwkv_v2[j - 1])
                vres_ctx = (v_first_ctx, rwkv_v0[j - 1], rwkv_v1[j - 1], rwkv_v2[j - 1])
            y_lat, y_ctx, v_lat, v_ctx = rwkv_mixer(n_lat, n_ctx, p, vres_lat, vres_ctx, not last)
            if j == 0:
                v_first_lat, v_first_ctx = v_lat, v_ctx
        elif kind == 1:
            y_lat, y_ctx = global_attention(n_lat, n_ctx, gattn_wq[j], gattn_wk[j], gattn_wv[j], gattn_wo[j],
                                            gattn_q_norm[j], gattn_k_norm[j], cos, sin, not last)
        else:
            y_lat, y_ctx = window_attention(n_lat, n_ctx, wattn_wq[j], wattn_wk[j], wattn_wv[j], wattn_wo[j],
                                            wattn_sink[j], cos, sin, not last)
        x = x + ml[5] * rms_norm(y_lat, g[3])
        x = ffn_half(x, ml[6], ml[7], ml[8], g[4], g[5], ffn_w1[i, 1], ffn_w3[i, 1], ffn_w2[i, 1])
        if not last:
            ctx = ctx + mc[5] * rms_norm(y_ctx, g[3])
            ctx = ffn_half(ctx, mc[6], mc[7], mc[8], g[4], g[5], ffn_w1[i, 1], ffn_w3[i, 1], ffn_w2[i, 1])
    return x
```

```cpp
#include <hip/hip_runtime.h>
#include <hip/hip_cooperative_groups.h>
#include <cstdint>
#include <cstdio>
namespace cg = cooperative_groups;

#define DEVI __device__ __forceinline__
typedef unsigned short bf16_t;
typedef short bf16x8 __attribute__((ext_vector_type(8)));
typedef short bf16x4 __attribute__((ext_vector_type(4)));
typedef float f32x4 __attribute__((ext_vector_type(4)));
typedef float f32x16 __attribute__((ext_vector_type(16)));

#ifndef ONE_LAUNCH
#define ONE_LAUNCH 1
#endif

constexpr int D = 1024, TL = 32768, TCX = 2048, T = TL + TCX, FF = 2816, LK = 4352;
constexpr int NT = 512;
constexpr size_t MiB = 1u << 20;
constexpr size_t WS_MOD = 0;
constexpr size_t WS_ROPE = 2 * MiB;
constexpr size_t WS_XC = 4 * MiB;
constexpr size_t WS_WB = 12 * MiB;
constexpr size_t WS_N1 = 64 * MiB;
constexpr size_t WS_N2 = 132 * MiB;
constexpr size_t WS_VF = 200 * MiB;
constexpr size_t WS_R = 268 * MiB;
constexpr size_t WS_END = 524 * MiB;
constexpr size_t WB_UP0 = 0, WB_UP1 = (size_t)5632 * 1024, WB_DN0 = 2 * WB_UP1, WB_DN1 = WB_DN0 + (size_t)1024 * 2816,
                 WB_MIX = WB_DN1 + (size_t)1024 * 2816, WB_WO = WB_MIX + (size_t)3840 * 2048, WB_G2T = WB_WO + (size_t)1024 * 1024;
constexpr size_t R_FL = (size_t)3 * T * 1024;
constexpr size_t R_QB = (size_t)T * 1536;
constexpr size_t R_KB = R_QB + (size_t)T * 1024;
constexpr size_t R_VT = R_KB + (size_t)8 * 4 * LK * 64;

struct Params {
  const float* in[42];
  float* out;
  unsigned char* ws;
  int ph_lo, ph_hi;
};

DEVI unsigned cvt_pk_bf16(float lo, float hi) { unsigned r; asm("v_cvt_pk_bf16_f32 %0, %1, %2" : "=v"(r) : "v"(lo), "v"(hi)); return r; }
DEVI float bflo(unsigned u) { return __uint_as_float(u << 16); }
DEVI float bfhi(unsigned u) { return __uint_as_float(u & 0xffff0000u); }
DEVI float rdlane(float v, int l) { return __builtin_bit_cast(float, __builtin_amdgcn_readlane(__builtin_bit_cast(int, v), l)); }
DEVI float xor32f(float v, int lane) { return __builtin_bit_cast(float, __builtin_amdgcn_ds_bpermute((lane ^ 32) << 2, __builtin_bit_cast(int, v))); }
template <int CTRL> DEVI float dppf(float v) { return __builtin_bit_cast(float, __builtin_amdgcn_update_dpp(0, __builtin_bit_cast(int, v), CTRL, 0xf, 0xf, true)); }
DEVI float red8(float v) { v += dppf<0xB1>(v); v += dppf<0x4E>(v); v += dppf<0x141>(v); return v; }
DEVI float red16(float v) { v = red8(v); v += dppf<0x140>(v); return v; }
DEVI float wave_sum(float v) { v = red16(v); return (rdlane(v, 0) + rdlane(v, 16)) + (rdlane(v, 32) + rdlane(v, 48)); }
typedef const __attribute__((address_space(4))) Params KParams;
DEVI int opaque_tid(int wave_s) { int t; asm volatile("v_mbcnt_lo_u32_b32 %0, -1, 0\n\tv_mbcnt_hi_u32_b32 %0, -1, %0\n\tv_lshl_add_u32 %0, %1, 6, %0" : "=&v"(t) : "s"(wave_s)); return t; }
DEVI float sigmoidf_(float x) { return __builtin_amdgcn_rcpf(1.f + __expf(-x)); }
DEVI float tanhf_(float x) { return 1.f - 2.f * __builtin_amdgcn_rcpf(1.f + __expf(2.f * x)); }

constexpr int BM = 256, BK = 64, HALF = 128, NXCD = 8, WGM = 8, HT = HALF * BK;
struct GemmArgs { const bf16_t* A1; const bf16_t* A2; int ksplit; int lda; const bf16_t* Bt; int M, N, K; int split; };

DEVI int lds_byte(int r, int c) { int st = (r >> 4) * 2 + (c >> 5), rr = r & 15, cc = c & 31, ob = rr * 64 + cc * 2; return st * 1024 + (ob ^ (((ob >> 9) & 1) << 5)); }
DEVI void stage_rc(int b, int& R, int& C) { int st = b / 1024, sb = b % 1024, swz = sb ^ (((sb >> 9) & 1) << 5); R = (st >> 1) * 16 + swz / 64; C = (st & 1) * 32 + (swz % 64) / 2; }

template <class Epi>
DEVI void gemm_phase(const GemmArgs& g, const Epi& epi, unsigned char* smem, int wave_s) {
  bf16_t* shm = (bf16_t*)smem;
#define SA(b, h) (shm + ((b) * 2 + (h)) * HT)
#define SB(b, h) (shm + (4 + (b) * 2 + (h)) * HT)
#define STAGE_B(P, br, kt) do { const char* _g = (const char*)(g.Bt + (size_t)(br) * K + koff + (size_t)(kt) * BK); \
    __builtin_amdgcn_global_load_lds((const unsigned*)(_g + ob0), (unsigned*)((char*)(P) + sb0), 16, 0, 0); \
    __builtin_amdgcn_global_load_lds((const unsigned*)(_g + ob1), (unsigned*)((char*)(P) + sb1), 16, 0, 0); } while (0)
#define STAGE_A(P, br, kt) do { const int _k0 = koff + (kt) * BK; const char* _g = (const char*)((_k0 < g.ksplit ? g.A1 + _k0 : g.A2 + (_k0 - g.ksplit)) + (size_t)(br) * lda); \
    __builtin_amdgcn_global_load_lds((const unsigned*)(_g + oa0), (unsigned*)((char*)(P) + sb0), 16, 0, 0); \
    __builtin_amdgcn_global_load_lds((const unsigned*)(_g + oa1), (unsigned*)((char*)(P) + sb1), 16, 0, 0); } while (0)
#define LDA(dst, b, h) for (int m = 0; m < 4; ++m) for (int k = 0; k < 2; ++k) \
    dst[m][k] = *reinterpret_cast<const bf16x8*>((char*)SA(b, h) + lds_byte(wr * 64 + m * 16 + fr, k * 32 + fq * 8))
#define LDB(dst, b, h) for (int n = 0; n < 2; ++n) for (int k = 0; k < 2; ++k) \
    dst[n][k] = *reinterpret_cast<const bf16x8*>((char*)SB(b, h) + lds_byte(wc * 32 + n * 16 + fr, k * 32 + fq * 8))
#define MMA(ai, bj, At_, Bt_) do { __builtin_amdgcn_s_setprio(1); \
    for (int m = 0; m < 4; ++m) for (int n = 0; n < 2; ++n) for (int k = 0; k < 2; ++k) \
      acc[ai][bj][m][n] = __builtin_amdgcn_mfma_f32_16x16x32_bf16(Bt_[n][k], At_[m][k], acc[ai][bj][m][n], 0, 0, 0); \
    __builtin_amdgcn_s_setprio(0); } while (0)
#define WAIT_V(n) asm volatile("s_waitcnt vmcnt(" #n ")" ::: "memory")
#define WAIT_L(n) asm volatile("s_waitcnt lgkmcnt(" #n ")" ::: "memory")
#define BAR __builtin_amdgcn_s_barrier()
#define SCHED __builtin_amdgcn_sched_barrier(0)
  const int K = g.K, lda = g.lda;
  const int nM = (g.split ? TL : g.M) / BM, nN = g.N / BM, nwg = nM * nN;
  const int nsp = g.split, nitems = nwg + (TCX / BM) * nN * nsp;
  const int ktot = K / BK, kbase = nsp ? ((ktot / nsp) & ~1) : 0;
  int sb0, sb1, wr, wc, fr, fq;
  unsigned oa0, oa1, ob0, ob1;
#define COMPUTE_OFFS() do { int tid_ = opaque_tid(wave_s); \
    const int wid_ = tid_ >> 6, lane_ = tid_ & 63; wr = wid_ >> 2; wc = wid_ & 3; fr = lane_ & 15; fq = lane_ >> 4; \
    sb0 = tid_ * 16; sb1 = tid_ * 16 + 8192; \
    int sr0, sc0, sr1, sc1; stage_rc(sb0, sr0, sc0); stage_rc(sb1, sr1, sc1); \
    oa0 = (unsigned)(sr0 * lda + sc0) * 2u; oa1 = (unsigned)(sr1 * lda + sc1) * 2u; ob0 = (unsigned)(sr0 * K + sc0) * 2u; ob1 = (unsigned)(sr1 * K + sc1) * 2u; } while (0)
  COMPUTE_OFFS();
  int brow = 0, bcol = 0, koff = 0, nt = 0, ks = -1;
#define TILE_COORDS(L_) do { \
    if ((L_) < nwg) { \
      int wgid = (L_); \
      { int q = nwg / NXCD, r = nwg % NXCD, xcd = wgid % NXCD, off = wgid / NXCD; wgid = (xcd < r ? xcd * (q + 1) : r * (q + 1) + (xcd - r) * q) + off; } \
      const int nig = WGM * nN, gid = wgid / nig, fm = gid * WGM, gsz = min(nM - fm, WGM); \
      const int pm = fm + ((wgid % nig) % gsz), pn = (wgid % nig) / gsz; \
      brow = pm * BM; bcol = pn * BM; koff = 0; nt = K / BK; ks = -1; \
    } else { \
      const int e = (L_) - nwg; ks = e % nsp; const int r = e / nsp; const int pn = r % nN, pmc = r / nN; \
      brow = TL + pmc * BM; bcol = pn * BM; koff = ks * kbase * BK; nt = (ks < nsp - 1) ? kbase : ktot - kbase * (nsp - 1); \
    } } while (0)
#define FIRST4() do { STAGE_B(SB(0, 0), bcol, 0); STAGE_A(SA(0, 0), brow, 0); STAGE_B(SB(0, 1), bcol + HALF, 0); STAGE_A(SA(0, 1), brow + HALF, 0); } while (0)
  int L = blockIdx.x;
  bool have = L < nitems;
  if (have) { TILE_COORDS(L); FIRST4(); }
  while (have) {
    f32x4 acc[2][2][4][2] = {};
    bf16x8 At[4][2], B0[2][2], B1[2][2];
    WAIT_V(0);
    if (wr == 1) BAR;
    BAR;
    STAGE_B(SB(1, 0), bcol, 1); STAGE_A(SA(1, 0), brow, 1); STAGE_B(SB(1, 1), bcol + HALF, 1);
    WAIT_V(6); BAR;
    for (int t = 0; t < nt - 2; t += 2) {
      LDB(B0, 0, 0); SCHED; LDA(At, 0, 0); STAGE_A(SA(1, 1), brow + HALF, t + 1);
      WAIT_L(8); BAR; WAIT_L(0); MMA(0, 0, At, B0); BAR; SCHED;
      LDB(B1, 0, 1); STAGE_B(SB(0, 0), bcol, t + 2);
      BAR; WAIT_L(0); MMA(0, 1, At, B1); BAR;
      LDA(At, 0, 1); STAGE_A(SA(0, 0), brow, t + 2);
      BAR; WAIT_L(0); MMA(1, 0, At, B0); BAR; SCHED;
      STAGE_B(SB(0, 1), bcol + HALF, t + 2);
      WAIT_V(6); BAR; MMA(1, 1, At, B1); BAR;
      LDB(B0, 1, 0); SCHED; LDA(At, 1, 0); STAGE_A(SA(0, 1), brow + HALF, t + 2);
      WAIT_L(8); BAR; WAIT_L(0); MMA(0, 0, At, B0); BAR; SCHED;
      LDB(B1, 1, 1); STAGE_B(SB(1, 0), bcol, t + 3);
      BAR; WAIT_L(0); MMA(0, 1, At, B1); BAR;
      LDA(At, 1, 1); STAGE_A(SA(1, 0), brow, t + 3);
      BAR; WAIT_L(0); MMA(1, 0, At, B0); BAR; SCHED;
      STAGE_B(SB(1, 1), bcol + HALF, t + 3);
      WAIT_V(6); BAR; MMA(1, 1, At, B1); BAR;
    }
    { LDB(B0, 0, 0); LDA(At, 0, 0); STAGE_A(SA(1, 1), brow + HALF, nt - 1);
      BAR; WAIT_L(0); MMA(0, 0, At, B0); BAR;
      LDB(B1, 0, 1); BAR; WAIT_L(0); MMA(0, 1, At, B1); BAR;
      LDA(At, 0, 1); WAIT_V(4); BAR; WAIT_L(0); MMA(1, 0, At, B0); MMA(1, 1, At, B1); BAR; }
    { LDB(B0, 1, 0); LDA(At, 1, 0); WAIT_V(2); BAR; WAIT_L(0); MMA(0, 0, At, B0); BAR;
      LDB(B1, 1, 1); WAIT_V(0); BAR; WAIT_L(0); MMA(0, 1, At, B1); BAR;
      LDA(At, 1, 1); BAR; WAIT_L(0); MMA(1, 0, At, B0); MMA(1, 1, At, B1); BAR; }
    if (wr == 0) BAR;
    const int cbrow = brow, cbcol = bcol, cks = ks;
    L += gridDim.x; have = L < nitems;
    if (have) { COMPUTE_OFFS(); TILE_COORDS(L); FIRST4(); }
    COMPUTE_OFFS();
    epi(acc, cbrow, cbcol, wr, wc, fr, fq, cks);
    COMPUTE_OFFS();
  }
#undef SA
#undef SB
}

DEVI int perm32(int rho) { const int n = rho >> 4, i = rho & 15; return 8 * (i >> 2) + 4 * n + (i & 3); }
DEVI int permrow(int R) { return (R & ~31) + perm32(R & 31); }
DEVI uint4 pack8(const f32x4& a, const f32x4& b) { uint4 w; w.x = cvt_pk_bf16(a[0], a[1]); w.y = cvt_pk_bf16(a[2], a[3]); w.z = cvt_pk_bf16(b[0], b[1]); w.w = cvt_pk_bf16(b[2], b[3]); return w; }
struct EpiSwiglu {
  bf16_t* H;
  DEVI void operator()(const f32x4 (&acc)[2][2][4][2], int brow, int bcol, int wr, int wc, int fr, int fq, int ks) const {
    const int hc0 = (bcol >> 1) + wc * 32 + fq * 8;
#pragma unroll
    for (int ai = 0; ai < 2; ++ai)
#pragma unroll
      for (int m = 0; m < 4; ++m) {
        const size_t row = brow + ai * 128 + wr * 64 + m * 16 + fr;
        f32x4 o[2];
#pragma unroll
        for (int n = 0; n < 2; ++n) {
          const f32x4 u = acc[ai][0][m][n], v = acc[ai][1][m][n];
#pragma unroll
          for (int e = 0; e < 4; ++e) o[n][e] = u[e] * __builtin_amdgcn_rcpf(1.f + __expf(-u[e])) * v[e];
        }
        *(uint4*)(H + row * FF + hc0) = pack8(o[0], o[1]);
      }
  }
};
struct EpiBf16 {
  bf16_t* O; int ldc; bf16_t* slab;
  DEVI void operator()(const f32x4 (&acc)[2][2][4][2], int brow, int bcol, int wr, int wc, int fr, int fq, int ks) const {
#pragma unroll
    for (int ai = 0; ai < 2; ++ai)
#pragma unroll
      for (int m = 0; m < 4; ++m) {
        const size_t row = brow + ai * 128 + wr * 64 + m * 16 + fr;
#pragma unroll
        for (int bj = 0; bj < 2; ++bj) {
          const uint4 w = pack8(acc[ai][bj][m][0], acc[ai][bj][m][1]);
          const int col = bcol + bj * 128 + wc * 32 + fq * 8;
          if (ks < 0) *(uint4*)(O + row * ldc + col) = w;
          else *(uint4*)(slab + ((size_t)ks * TCX + (row - TL)) * 1024 + col) = w;
        }
      }
  }
};
struct EpiFeat {
  bf16_t* Fr; bf16_t* Fl; bf16_t* VF; int dup_v;
  DEVI void operator()(const f32x4 (&acc)[2][2][4][2], int brow, int bcol, int wr, int wc, int fr, int fq, int ks) const {
#pragma unroll
    for (int bj = 0; bj < 2; ++bj) {
      const int col = bcol + bj * 128 + wc * 32 + fq * 8;
      int act = 0;
      if (col >= 3072) { const int q = col - 3072; if (q < 256) act = ((q >> 6) & 1) ? 0 : 1; else if (q < 672) act = 2; else act = 0; }
#pragma unroll
      for (int ai = 0; ai < 2; ++ai)
#pragma unroll
        for (int m = 0; m < 4; ++m) {
          const size_t row = brow + ai * 128 + wr * 64 + m * 16 + fr;
          f32x4 u0 = acc[ai][bj][m][0], u1 = acc[ai][bj][m][1];
          if (act == 1) { for (int e = 0; e < 4; ++e) { u0[e] = tanhf_(u0[e]); u1[e] = tanhf_(u1[e]); } }
          else if (act == 2) { for (int e = 0; e < 4; ++e) { u0[e] = sigmoidf_(u0[e]); u1[e] = sigmoidf_(u1[e]); } }
          const uint4 w = pack8(u0, u1);
          if (col < 3072) {
            *(uint4*)(Fr + (size_t)(col >> 10) * T * 1024 + row * 1024 + (col & 1023)) = w;
            if (dup_v && col >= 2048) *(uint4*)(VF + row * 1024 + (col & 1023)) = w;
          } else {
            *(uint4*)(Fl + row * 768 + (col - 3072)) = w;
          }
        }
    }
  }
};
struct EpiReadout {
  bf16_t* O; const bf16_t* Z; int add;
  DEVI void operator()(const f32x4 (&acc)[2][2][4][2], int brow, int bcol, int wr, int wc, int fr, int fq, int ks) const {
#pragma unroll
    for (int ai = 0; ai < 2; ++ai)
#pragma unroll
      for (int m = 0; m < 4; ++m) {
        const size_t row = brow + ai * 128 + wr * 64 + m * 16 + fr;
#pragma unroll
        for (int bj = 0; bj < 2; ++bj) {
          const size_t idx = row * 1024 + bcol + bj * 128 + wc * 32 + fq * 8;
          const f32x4 u0 = acc[ai][bj][m][0], u1 = acc[ai][bj][m][1];
          const uint4 z = *(const uint4*)(Z + idx);
          f32x4 o0 = {u0[0] * bflo(z.x), u0[1] * bfhi(z.x), u0[2] * bflo(z.y), u0[3] * bfhi(z.y)};
          f32x4 o1 = {u1[0] * bflo(z.z), u1[1] * bfhi(z.z), u1[2] * bflo(z.w), u1[3] * bfhi(z.w)};
          if (add) { const uint4 p = *(const uint4*)(O + idx);
            o0 += (f32x4){bflo(p.x), bfhi(p.x), bflo(p.y), bfhi(p.y)}; o1 += (f32x4){bflo(p.z), bfhi(p.z), bflo(p.w), bfhi(p.w)}; }
          *(uint4*)(O + idx) = pack8(o0, o1);
        }
      }
  }
};

DEVI void mod_job(KParams& p, int job, float* sm, int wave_s) {
  const int tid = opaque_tid(wave_s);
  const int i = job / 72, col0 = (job % 72) * 128;
  float* sc = sm;
  float* red = sm + 9 * 1024;
  const float* c = p.in[1]; const float* cc = p.in[3];
  for (int e = tid; e < 9 * 1024; e += NT) { const int r = e >> 10, k = e & 1023; const float v = r < 8 ? c[r * 1024 + k] : cc[k]; sc[e] = v / (1.f + expf(-v)); }
  __syncthreads();
  const int cq = tid & 31, ks = tid >> 5;
  const float* w = p.in[4] + (size_t)i * 1024 * 9216 + col0 + cq * 4;
  f32x4 acc[9];
#pragma unroll
  for (int r = 0; r < 9; ++r) acc[r] = (f32x4){0.f, 0.f, 0.f, 0.f};
  for (int k = ks * 64; k < ks * 64 + 64; ++k) {
    const f32x4 w4 = *(const f32x4*)(w + (size_t)k * 9216);
#pragma unroll
    for (int r = 0; r < 9; ++r) acc[r] += sc[r * 1024 + k] * w4;
  }
#pragma unroll
  for (int r = 0; r < 9; ++r) *(f32x4*)(red + (ks * 9 + r) * 128 + cq * 4) = acc[r];
  __syncthreads();
  float* MOD = (float*)(p.ws + WS_MOD);
  for (int e = tid; e < 9 * 128; e += NT) {
    const int r = e >> 7, c_ = e & 127;
    float s = p.in[5][i * 9216 + col0 + c_];
    for (int k2 = 0; k2 < 16; ++k2) s += red[(k2 * 9 + r) * 128 + c_];
    MOD[(size_t)(i * 9 + r) * 9216 + col0 + c_] = s;
  }
  __syncthreads();
}

template <class F> DEVI void conv_seg(bf16_t* dst, int ld, int nrows, int ncols, F f, unsigned char* smem, int wave_s) {
  uint4* tile = (uint4*)smem;
  const int tid0 = opaque_tid(wave_s);
  const int tn = nrows >> 6, tk = ncols >> 6, ntiles = tn * tk;
  for (int t = blockIdx.x; t < ntiles; t += gridDim.x) {
    const int n0 = (t % tn) << 6, k0 = (t / tn) << 6;
    {
      const int nl = tid0 & 63, kl = tid0 >> 6;
      float v[8];
#pragma unroll
      for (int i = 0; i < 8; ++i) v[i] = f(n0 + nl, k0 + kl * 8 + i);
      uint4 o; o.x = cvt_pk_bf16(v[0], v[1]); o.y = cvt_pk_bf16(v[2], v[3]); o.z = cvt_pk_bf16(v[4], v[5]); o.w = cvt_pk_bf16(v[6], v[7]);
      tile[nl * 8 + (kl ^ (nl & 7))] = o;
    }
    __syncthreads();
    {
      const int row = tid0 >> 3, ch = tid0 & 7;
      *(uint4*)(dst + (size_t)(n0 + row) * ld + k0 + ch * 8) = tile[row * 8 + (ch ^ (row & 7))];
    }
    __syncthreads();
  }
}

DEVI void conv_layer(KParams& p, int i, unsigned char* smem, int wave_s) {
  bf16_t* wb = (bf16_t*)(p.ws + WS_WB);
  for (int h = 0; h < 2; ++h) {
    const float* w1 = p.in[7] + (size_t)(i * 2 + h) * D * FF;
    const float* w3 = p.in[8] + (size_t)(i * 2 + h) * D * FF;
    conv_seg(wb + WB_UP0 + (size_t)h * 5632 * 1024, 1024, 5632, 1024, [=](int R0, int k) -> float {
      const int R = permrow(R0); const int cidx = (R >> 8) * 128 + (R & 127); const float* s = ((R >> 7) & 1) ? w3 : w1; return s[(size_t)k * FF + cidx]; }, smem, wave_s);
    const float* w2 = p.in[9] + (size_t)(i * 2 + h) * FF * D;
    conv_seg(wb + WB_DN0 + (size_t)h * 1024 * 2816, 2816, 1024, 2816, [=](int n0, int k) -> float { const int n = permrow(n0); return w2[(size_t)k * D + n]; }, smem, wave_s);
  }
  const int kind = i % 3, j = i / 3;
  if (kind == 0) {
    const float* mu = p.in[10] + (size_t)j * 6 * 1024;
    const float* wr = p.in[11] + (size_t)j * D * D; const float* wk = p.in[12] + (size_t)j * D * D; const float* wv = p.in[13] + (size_t)j * D * D;
    const float* w1 = p.in[19] + (size_t)j * 2 * 1024 * 64; const float* a1 = p.in[22] + (size_t)j * 2 * 1024 * 64;
    const float* g1 = p.in[24] + (size_t)j * 2 * 1024 * 160; const float* v1 = j > 0 ? p.in[29] + (size_t)(j - 1) * 1024 * 32 : nullptr;
    conv_seg(wb + WB_MIX, 2048, 3840, 2048, [=](int R0, int k) -> float {
      const int R = permrow(R0); const int kk = k & 1023; const float* s; int ld, col, m;
      if (R < 3072) { const int which = R >> 10; s = which == 0 ? wr : (which == 1 ? wk : wv); ld = 1024; col = R & 1023; m = which == 0 ? 0 : (which == 1 ? 2 : 3); }
      else { const int q = R - 3072;
        if (q < 256) { const int dd = q >> 7, sub = (q >> 6) & 1; col = q & 63; ld = 64; s = (sub ? a1 : w1) + (size_t)dd * 1024 * 64; m = sub ? 4 : 1; }
        else if (q < 416) { s = g1; ld = 160; col = q - 256; m = 5; }
        else if (q < 512) return 0.f;
        else if (q < 672) { s = g1 + (size_t)1024 * 160; ld = 160; col = q - 512; m = 5; }
        else if (q < 704) { if (!v1) return 0.f; s = v1; ld = 32; col = q - 672; m = 3; }
        else return 0.f; }
      const float w = s[(size_t)kk * ld + col]; const float muv = mu[m * 1024 + kk];
      return k < 1024 ? w * (1.f - muv) : w * muv; }, smem, wave_s);
    const float* wo = p.in[14] + (size_t)j * D * D;
    conv_seg(wb + WB_WO, 1024, 1024, 1024, [=](int n0, int k) -> float { const int n = permrow(n0); return wo[(size_t)k * D + n]; }, smem, wave_s);
    const float* g2 = p.in[25] + (size_t)j * 2 * 160 * 1024;
    for (int d = 0; d < 2; ++d)
      conv_seg(wb + WB_G2T + (size_t)d * 1024 * 256, 256, 1024, 256, [=](int n0, int k) -> float { const int n = permrow(n0); return k < 160 ? g2[((size_t)d * 160 + k) * 1024 + n] : 0.f; }, smem, wave_s);
  } else {
    const int o = kind == 1 ? 31 : 37;
    const float* wq = p.in[o]; const float* wk = p.in[o + 1]; const float* wv = p.in[o + 2]; const float* wo = p.in[o + 3];
    conv_seg(wb + WB_MIX, 1024, 1536, 1024, [=](int R0, int k) -> float {
      const int R = permrow(R0); return R < 1024 ? wq[(size_t)k * 1024 + R] : (R < 1280 ? wk[(size_t)k * 256 + (R - 1024)] : wv[(size_t)k * 256 + (R - 1280)]); }, smem, wave_s);
    conv_seg(wb + WB_WO, 1024, 1024, 1024, [=](int n0, int k) -> float { const int n = permrow(n0); return wo[(size_t)k * D + n]; }, smem, wave_s);
  }
}

DEVI void rope_table(KParams& p, int wave_s) {
  float2* rt = (float2*)(p.ws + WS_ROPE);
  const int tid0 = opaque_tid(wave_s);
  for (int idx = blockIdx.x * NT + tid0; idx < 4096 * 32; idx += gridDim.x * NT) {
    const int pos = idx >> 5, axis = (idx >> 4) & 1, f = idx & 15;
    const float inv = powf(10000.f, -(float)f / 16.f);
    const float ang = (float)(axis ? (pos & 63) : (pos >> 6)) * inv;
    float s, c; sincosf(ang, &s, &c);
    rt[idx] = make_float2(c, s);
  }
}

struct RowPass {
  const float* xl; const float* xc; float* ol; float* oc;
  const bf16_t* y; const bf16_t* yslab; int nslab; const float* gpost; const float* modg; int mgate; float coef;
  bf16_t* n; const float* gpre; const float* modn; int mshift, mscale; int tmax;
};
DEVI void rowpass(const RowPass& a, int wave_s) {
  const int tid0 = opaque_tid(wave_s);
  const int wave = tid0 >> 6, lane = tid0 & 63;
  const int stride = gridDim.x * 8;
  int t = blockIdx.x * 8 + wave;
  if (t >= a.tmax) return;
  const bool upd = a.y != nullptr, nrm = a.n != nullptr;
  f32x4 gp[4], gpre[4], gt[4], sh[4], sc[4];
#pragma unroll
  for (int q = 0; q < 4; ++q) {
    const int c = q * 256 + lane * 4;
    gp[q] = upd ? *(const f32x4*)(a.gpost + c) : (f32x4){0.f, 0.f, 0.f, 0.f};
    gpre[q] = nrm ? *(const f32x4*)(a.gpre + c) : (f32x4){0.f, 0.f, 0.f, 0.f};
    gt[q] = gp[q]; sh[q] = gp[q]; sc[q] = gp[q];
  }
  int rcur = -1;
  f32x4 xA[4]; uint2 yA[4];
#define RP_LOAD(X_, Y_, t_) do { const bool lat_ = (t_) < TL; \
    const float* xs_ = lat_ ? a.xl + (size_t)(t_) * D : a.xc + (size_t)((t_) - TL) * D; \
    for (int q = 0; q < 4; ++q) X_[q] = __builtin_nontemporal_load((const f32x4*)(xs_ + q * 256 + lane * 4)); \
    if (upd && (lat_ || a.nslab == 0)) { for (int q = 0; q < 4; ++q) Y_[q] = *(const uint2*)(a.y + (size_t)(t_) * D + q * 256 + lane * 4); } } while (0)
  f32x4 xB[4]; uint2 yB[4];
  RP_LOAD(xA, yA, t);
#pragma unroll
  for (int q = 0; q < 4; ++q) { xB[q] = xA[q]; yB[q] = yA[q]; }
  if (t + stride < a.tmax) RP_LOAD(xB, yB, t + stride);
  while (true) {
    const int tn = t + stride;
    const bool more = tn < a.tmax;
    f32x4 xC[4]; uint2 yC[4];
#pragma unroll
    for (int q = 0; q < 4; ++q) { xC[q] = xB[q]; yC[q] = yB[q]; }
    if (tn + stride < a.tmax) RP_LOAD(xC, yC, tn + stride);
    const bool lat = t < TL; const int r = lat ? (t >> 12) : 8;
    if (r != rcur) {
      rcur = r;
#pragma unroll
      for (int q = 0; q < 4; ++q) {
        const int c = q * 256 + lane * 4;
        if (upd) gt[q] = *(const f32x4*)(a.modg + (size_t)r * 9216 + a.mgate * 1024 + c);
        if (nrm) { sh[q] = *(const f32x4*)(a.modn + (size_t)r * 9216 + a.mshift * 1024 + c); sc[q] = *(const f32x4*)(a.modn + (size_t)r * 9216 + a.mscale * 1024 + c); }
      }
    }
    float* xo = lat ? a.ol + (size_t)t * D : a.oc + (size_t)(t - TL) * D;
    f32x4 x[4];
#pragma unroll
    for (int q = 0; q < 4; ++q) x[q] = xA[q];
    if (upd) {
      f32x4 yv[4]; float ss = 0.f;
#pragma unroll
      for (int q = 0; q < 4; ++q) {
        if (lat || a.nslab == 0) {
          yv[q] = (f32x4){bflo(yA[q].x), bfhi(yA[q].x), bflo(yA[q].y), bfhi(yA[q].y)};
        } else {
          yv[q] = (f32x4){0.f, 0.f, 0.f, 0.f};
          for (int sl = 0; sl < a.nslab; ++sl) {
            const uint2 u = *(const uint2*)(a.yslab + ((size_t)sl * TCX + (t - TL)) * D + q * 256 + lane * 4);
            yv[q] += (f32x4){bflo(u.x), bfhi(u.x), bflo(u.y), bfhi(u.y)};
          }
        }
        ss += yv[q][0] * yv[q][0] + yv[q][1] * yv[q][1] + yv[q][2] * yv[q][2] + yv[q][3] * yv[q][3];
      }
      ss = wave_sum(ss);
      const float rs = __builtin_amdgcn_rsqf(ss * (1.f / D) + 1e-6f);
#pragma unroll
      for (int q = 0; q < 4; ++q) {
        x[q] += a.coef * gt[q] * (yv[q] * rs * gp[q]);
        __builtin_nontemporal_store(x[q], (f32x4*)(xo + q * 256 + lane * 4));
      }
    }
    if (nrm) {
      float ss = 0.f;
#pragma unroll
      for (int q = 0; q < 4; ++q) ss += x[q][0] * x[q][0] + x[q][1] * x[q][1] + x[q][2] * x[q][2] + x[q][3] * x[q][3];
      ss = wave_sum(ss);
      const float rs = __builtin_amdgcn_rsqf(ss * (1.f / D) + 1e-6f);
#pragma unroll
      for (int q = 0; q < 4; ++q) {
        const f32x4 v = x[q] * rs * gpre[q] * (1.f + sc[q]) + sh[q];
        uint2 w; w.x = cvt_pk_bf16(v[0], v[1]); w.y = cvt_pk_bf16(v[2], v[3]);
        *(uint2*)(a.n + (size_t)t * D + q * 256 + lane * 4) = w;
      }
    }
    if (!more) break;
#pragma unroll
    for (int q = 0; q < 4; ++q) { xA[q] = xB[q]; yA[q] = yB[q]; xB[q] = xC[q]; yB[q] = yC[q]; }
    t = tn;
  }
#undef RP_LOAD
}

DEVI void shift_phase(const bf16_t* n, bf16_t* s, int wave_s) {
  const int tid0 = opaque_tid(wave_s);
  for (int idx = blockIdx.x * NT + tid0; idx < T * 128; idx += gridDim.x * NT) {
    const int t = idx >> 7, c = (idx & 127) * 8;
    const bool lat = t < TL; const int pos = lat ? (t & 4095) : ((t - TL) & 255); const int last = lat ? 4095 : 255;
    uint4 a = {0, 0, 0, 0}, b = {0, 0, 0, 0};
    if (pos > 0) a = *(const uint4*)(n + (size_t)(t - 1) * D + c);
    if (pos < last) b = *(const uint4*)(n + (size_t)(t + 1) * D + c);
    uint4 o;
    o.x = cvt_pk_bf16(0.5f * (bflo(a.x) + bflo(b.x)), 0.5f * (bfhi(a.x) + bfhi(b.x)));
    o.y = cvt_pk_bf16(0.5f * (bflo(a.y) + bflo(b.y)), 0.5f * (bfhi(a.y) + bfhi(b.y)));
    o.z = cvt_pk_bf16(0.5f * (bflo(a.z) + bflo(b.z)), 0.5f * (bfhi(a.z) + bfhi(b.z)));
    o.w = cvt_pk_bf16(0.5f * (bflo(a.w) + bflo(b.w)), 0.5f * (bfhi(a.w) + bfhi(b.w)));
    *(uint4*)(s + (size_t)t * D + c) = o;
  }
}

DEVI void head16(float (&v)[16], int qq, bool do_norm, const float* gvec, bool do_rope, const float2* rt_pos, float scale) {
  if (do_norm) {
    float ss = 0.f;
#pragma unroll
    for (int e = 0; e < 16; ++e) ss += v[e] * v[e];
    ss += dppf<0xB1>(ss); ss += dppf<0x4E>(ss);
    const float rs = 1.f / sqrtf(ss * (1.f / 64.f) + 1e-6f);
#pragma unroll
    for (int e = 0; e < 16; ++e) v[e] = v[e] * rs * gvec[qq * 16 + e];
  }
  float pv[16];
#pragma unroll
  for (int e = 0; e < 16; ++e) pv[e] = dppf<0xB1>(v[e]);
  if (do_rope) {
    const int axis = qq >> 1, half = qq & 1;
#pragma unroll
    for (int e = 0; e < 16; ++e) {
      const float2 cs = rt_pos[axis * 16 + e];
      v[e] = half ? (v[e] * cs.x + pv[e] * cs.y) : (v[e] * cs.x - pv[e] * cs.y);
    }
  }
#pragma unroll
  for (int e = 0; e < 16; ++e) v[e] *= scale;
}
DEVI void load16(const bf16_t* src, float (&v)[16]) {
  const uint4 a = *(const uint4*)src, b = *(const uint4*)(src + 8);
  v[0] = bflo(a.x); v[1] = bfhi(a.x); v[2] = bflo(a.y); v[3] = bfhi(a.y); v[4] = bflo(a.z); v[5] = bfhi(a.z); v[6] = bflo(a.w); v[7] = bfhi(a.w);
  v[8] = bflo(b.x); v[9] = bfhi(b.x); v[10] = bflo(b.y); v[11] = bfhi(b.y); v[12] = bflo(b.z); v[13] = bfhi(b.z); v[14] = bflo(b.w); v[15] = bfhi(b.w);
}
DEVI void store16(bf16_t* dst, const float (&v)[16]) {
  uint4 a, b;
  a.x = cvt_pk_bf16(v[0], v[1]); a.y = cvt_pk_bf16(v[2], v[3]); a.z = cvt_pk_bf16(v[4], v[5]); a.w = cvt_pk_bf16(v[6], v[7]);
  b.x = cvt_pk_bf16(v[8], v[9]); b.y = cvt_pk_bf16(v[10], v[11]); b.z = cvt_pk_bf16(v[12], v[13]); b.w = cvt_pk_bf16(v[14], v[15]);
  *(uint4*)dst = a; *(uint4*)(dst + 8) = b;
}
DEVI void attn_post(KParams& p, int mode, unsigned char* smem, int wave_s) {
  bf16_t* R = (bf16_t*)(p.ws + WS_R);
  const bf16_t* QKV = R; bf16_t* Qb = R + R_QB; bf16_t* Kb = R + R_KB; bf16_t* Vt = R + R_VT;
  const float2* rt = (const float2*)(p.ws + WS_ROPE);
  const float* gq = p.in[35]; const float* gk = p.in[36];
  bf16_t* Vs = (bf16_t*)smem;
  const int tid = opaque_tid(wave_s), wave = tid >> 6, lane = tid & 63;
  const float qscale = 0.125f * 1.4426950408889634f;
  for (int job = blockIdx.x; job < T / 64; job += gridDim.x) {
    const int t0 = job * 64; const bool lat = t0 < TL;
    const int b = lat ? (t0 >> 12) : ((t0 - TL) >> 8);
    const int key0 = lat ? (t0 & 4095) : (4096 + ((t0 - TL) & 255));
    for (int it = 0; it < 8; ++it) {
      const int tt = it * 8 + wave; const int t = t0 + tt;
      const int pos = lat ? (t & 4095) : 0;
      const bf16_t* raw = QKV + (size_t)t * 1536;
      const float2* rtp = rt + pos * 32;
      float v[16];
      load16(raw + lane * 16, v);
      head16(v, lane & 3, mode == 0, gq, lat, rtp, qscale);
      store16(Qb + (size_t)t * 1024 + lane * 16, v);
      const int kl = lane & 15;
      load16(raw + 1024 + kl * 16, v);
      head16(v, lane & 3, mode == 0, gk, lat, rtp, 1.f);
      if (lane < 16) store16(Kb + ((size_t)(b * 4 + (kl >> 2)) * LK + key0 + tt) * 64 + (kl & 3) * 16, v);
      if (lane < 32) {
        const uint4 u = *(const uint4*)(raw + 1280 + lane * 8);
        const int r0 = lane * 8;
        Vs[(r0 + 0) * 72 + tt] = (bf16_t)(u.x & 0xffff); Vs[(r0 + 1) * 72 + tt] = (bf16_t)(u.x >> 16);
        Vs[(r0 + 2) * 72 + tt] = (bf16_t)(u.y & 0xffff); Vs[(r0 + 3) * 72 + tt] = (bf16_t)(u.y >> 16);
        Vs[(r0 + 4) * 72 + tt] = (bf16_t)(u.z & 0xffff); Vs[(r0 + 5) * 72 + tt] = (bf16_t)(u.z >> 16);
        Vs[(r0 + 6) * 72 + tt] = (bf16_t)(u.w & 0xffff); Vs[(r0 + 7) * 72 + tt] = (bf16_t)(u.w >> 16);
      }
    }
    __syncthreads();
    {
      const int row = tid >> 1, hf = tid & 1;
      bf16_t* dst = Vt + ((size_t)b * 256 + row) * LK + key0 + hf * 32;
      const bf16_t* src = Vs + row * 72 + hf * 32;
#pragma unroll
      for (int i = 0; i < 4; ++i) *(uint4*)(dst + i * 8) = *(const uint4*)(src + i * 8);
    }
    __syncthreads();
  }
}

DEVI void attn_core(KParams& p, int mode, unsigned char* smem, int wave_s) {
  bf16_t* R = (bf16_t*)(p.ws + WS_R);
  const bf16_t* Qb = R + R_QB; const bf16_t* Kb = R + R_KB; const bf16_t* Vt = R + R_VT; bf16_t* O = R;
  const float* sink = p.in[41];
  bf16_t* KV = (bf16_t*)smem;
  const int tid = opaque_tid(wave_s), wave = tid >> 6, lane = tid & 63, l31 = lane & 31, hi = lane >> 5;
  const int nlat = 8 * 16 * 8, nitems = nlat + 8 * 16;
  for (int item = blockIdx.x; item < nitems; item += gridDim.x) {
    int b, h, q0; bool lat;
    if (item < nlat && gridDim.x == 256) {
      lat = true; const int rnd = item >> 8, bid_ = item & 255, xcd = bid_ & 7, slot = bid_ >> 3;
      const int grp = rnd * 8 + xcd;
      b = grp >> 2; const int kvh = grp & 3, g = slot >> 3, qb = slot & 7; h = kvh * 4 + g; q0 = qb * 512; }
    else if (item < nlat) { lat = true; b = item >> 7; const int kvh = (item >> 5) & 3, g = (item >> 3) & 3, qb = item & 7; h = kvh * 4 + g; q0 = qb * 512; }
    else { lat = false; const int r = item - nlat; b = r >> 4; h = r & 15; q0 = 0; }
    const int kvh = h >> 2;
    int qrow[2]; size_t tq[2];
    bf16x8 bq[2][4];
#pragma unroll
    for (int rg = 0; rg < 2; ++rg) {
      const int rloc = wave * 64 + rg * 32 + l31;
      qrow[rg] = lat ? q0 + rloc : (rloc & 255);
      tq[rg] = lat ? ((size_t)b * 4096 + qrow[rg]) : ((size_t)TL + b * 256 + qrow[rg]);
#pragma unroll
      for (int ks = 0; ks < 4; ++ks) bq[rg][ks] = *(const bf16x8*)(Qb + tq[rg] * 1024 + h * 64 + ks * 16 + hi * 8);
    }
    int a0 = 0, a1 = 0;
    if (lat) { if (mode == 0) { a0 = 0; a1 = 64; } else { a0 = max(0, q0 - 128) >> 6; a1 = min(4096, q0 + 512 + 128) >> 6; } }
    const int n1 = a1 - a0, ntile = n1 + 4;
    float m_run[2], l_run[2];
    f32x16 ot[2][2];
#pragma unroll
    for (int rg = 0; rg < 2; ++rg) {
      if (mode == 1) { m_run[rg] = sink[h] * 1.4426950408889634f; l_run[rg] = hi == 0 ? 1.f : 0.f; } else { m_run[rg] = -1e30f; l_run[rg] = 0.f; }
#pragma unroll
      for (int e = 0; e < 16; ++e) { ot[rg][0][e] = 0.f; ot[rg][1][e] = 0.f; }
    }
    const bf16_t* Kbase = Kb + (size_t)(b * 4 + kvh) * LK * 64;
    const bf16_t* Vbase = Vt + (size_t)(b * 4 + kvh) * 64 * LK;
    const int ldrow = tid >> 3, ldseg = tid & 7;
    uint4 kreg, vreg;
#define KT_OF(it_) ((it_) < n1 ? a0 + (it_) : 64 + ((it_) - n1))
#define KV_LOAD(it_) do { const int kt_ = KT_OF(it_); \
      kreg = *(const uint4*)(Kbase + ((size_t)kt_ * 64 + ldrow) * 64 + ldseg * 8); \
      vreg = *(const uint4*)(Vbase + (size_t)ldrow * LK + kt_ * 64 + ldseg * 8); } while (0)
#define KV_STORE(buf_) do { *(uint4*)(KV + (buf_) * 9216 + ldrow * 72 + ldseg * 8) = kreg; *(uint4*)(KV + (buf_) * 9216 + 4608 + ldrow * 72 + ldseg * 8) = vreg; } while (0)
    __syncthreads();
    KV_LOAD(0); KV_STORE(0);
    if (ntile > 1) KV_LOAD(1);
    __syncthreads();
    for (int it = 0; it < ntile; ++it) {
      const int kt = KT_OF(it);
      const bf16_t* Ks = KV + (it & 1) * 9216;
      const bf16_t* Vts = Ks + 4608;
      if (it + 1 < ntile) KV_STORE((it + 1) & 1);
      if (it + 2 < ntile) KV_LOAD(it + 2);
      const int wq0 = q0 + wave * 64;
      const bool act = !(mode == 1 && lat && kt < 64) || (kt * 64 + 63 >= wq0 - 128 && kt * 64 <= wq0 + 63 + 128);
      if (act) {
      f32x16 st[2][2];
#pragma unroll
      for (int kb = 0; kb < 2; ++kb) {
#pragma unroll
        for (int e = 0; e < 16; ++e) { st[0][kb][e] = 0.f; st[1][kb][e] = 0.f; }
#pragma unroll
        for (int ks = 0; ks < 4; ++ks) {
          const bf16x8 ak = *(const bf16x8*)(Ks + (kb * 32 + l31) * 72 + ks * 16 + hi * 8);
          st[0][kb] = __builtin_amdgcn_mfma_f32_32x32x16_bf16(ak, bq[0][ks], st[0][kb], 0, 0, 0);
          st[1][kb] = __builtin_amdgcn_mfma_f32_32x32x16_bf16(ak, bq[1][ks], st[1][kb], 0, 0, 0);
        }
      }
      unsigned pk[2][2][2][4];
#pragma unroll
      for (int rg = 0; rg < 2; ++rg) {
        if (mode == 1 && kt < 64) {
#pragma unroll
          for (int kb = 0; kb < 2; ++kb)
#pragma unroll
            for (int e = 0; e < 16; ++e) {
              const int key = kt * 64 + kb * 32 + 8 * (e >> 2) + 4 * hi + (e & 3);
              const int rel = key - qrow[rg];
              if (rel > 128 || rel < -128) st[rg][kb][e] = -1e30f;
            }
        }
        float lmax = st[rg][0][0];
#pragma unroll
        for (int kb = 0; kb < 2; ++kb)
#pragma unroll
          for (int e = 0; e < 16; ++e) lmax = fmaxf(lmax, st[rg][kb][e]);
        if (__builtin_amdgcn_ballot_w64(lmax > m_run[rg] + 8.f) != 0) {
          float mx = fmaxf(m_run[rg], lmax);
          mx = fmaxf(mx, xor32f(mx, lane));
          const float alpha = __builtin_amdgcn_exp2f(m_run[rg] - mx);
          m_run[rg] = mx; l_run[rg] *= alpha;
#pragma unroll
          for (int e = 0; e < 16; ++e) { ot[rg][0][e] *= alpha; ot[rg][1][e] *= alpha; }
        }
        const float mx = m_run[rg];
#pragma unroll
        for (int kb = 0; kb < 2; ++kb)
#pragma unroll
          for (int e = 0; e < 16; ++e) { const float pe = __builtin_amdgcn_exp2f(st[rg][kb][e] - mx); st[rg][kb][e] = pe; l_run[rg] += pe; }
#pragma unroll
        for (int kb = 0; kb < 2; ++kb)
#pragma unroll
          for (int ip = 0; ip < 2; ++ip) {
            pk[rg][kb][ip][0] = cvt_pk_bf16(st[rg][kb][8 * ip + 0], st[rg][kb][8 * ip + 1]); pk[rg][kb][ip][1] = cvt_pk_bf16(st[rg][kb][8 * ip + 2], st[rg][kb][8 * ip + 3]);
            pk[rg][kb][ip][2] = cvt_pk_bf16(st[rg][kb][8 * ip + 4], st[rg][kb][8 * ip + 5]); pk[rg][kb][ip][3] = cvt_pk_bf16(st[rg][kb][8 * ip + 6], st[rg][kb][8 * ip + 7]);
          }
      }
#pragma unroll
      for (int kb = 0; kb < 2; ++kb)
#pragma unroll
        for (int ip = 0; ip < 2; ++ip) {
          union { unsigned u[4]; bf16x8 v; } pb0, pb1;
#pragma unroll
          for (int q = 0; q < 4; ++q) { pb0.u[q] = pk[0][kb][ip][q]; pb1.u[q] = pk[1][kb][ip][q]; }
          const int keyoff = kb * 32 + ip * 16 + 4 * hi;
#pragma unroll
          for (int db = 0; db < 2; ++db) {
            union { uint2 u[2]; bf16x8 v; } av;
            av.u[0] = *(const uint2*)(Vts + (db * 32 + l31) * 72 + keyoff);
            av.u[1] = *(const uint2*)(Vts + (db * 32 + l31) * 72 + keyoff + 8);
            ot[0][db] = __builtin_amdgcn_mfma_f32_32x32x16_bf16(av.v, pb0.v, ot[0][db], 0, 0, 0);
            ot[1][db] = __builtin_amdgcn_mfma_f32_32x32x16_bf16(av.v, pb1.v, ot[1][db], 0, 0, 0);
          }
        }
      }
      __syncthreads();
    }
#pragma unroll
    for (int rg = 0; rg < 2; ++rg) {
      const float ltot = l_run[rg] + xor32f(l_run[rg], lane);
      const float inv = 1.f / ltot;
#pragma unroll
      for (int db = 0; db < 2; ++db)
#pragma unroll
        for (int i = 0; i < 4; ++i) {
          uint2 w; w.x = cvt_pk_bf16(ot[rg][db][4 * i] * inv, ot[rg][db][4 * i + 1] * inv); w.y = cvt_pk_bf16(ot[rg][db][4 * i + 2] * inv, ot[rg][db][4 * i + 3] * inv);
          *(uint2*)(O + tq[rg] * 1024 + h * 64 + db * 32 + 8 * i + 4 * hi) = w;
        }
    }
  }
}

typedef float f32x2 __attribute__((ext_vector_type(2)));
struct StepOps { f32x4 a0, a1, w0, w1, k0, k1, b0, b1, r0, r1; f32x2 v; f32x2 sc; };
constexpr int OPS_STRIDE = 6 * 2048 + 64;
DEVI void scan_load(StepOps& o, const float* base, int off, int kq, int r2) {
  const float* q = base + off + kq * 8;
  o.w0 = *(const f32x4*)(q); o.w1 = *(const f32x4*)(q + 4);
  o.k0 = *(const f32x4*)(q + 2048); o.k1 = *(const f32x4*)(q + 2048 + 4);
  o.a0 = *(const f32x4*)(q + 4096); o.a1 = *(const f32x4*)(q + 4096 + 4);
  o.b0 = *(const f32x4*)(q + 6144); o.b1 = *(const f32x4*)(q + 6144 + 4);
  o.r0 = *(const f32x4*)(q + 8192); o.r1 = *(const f32x4*)(q + 8192 + 4);
  o.v = *(const f32x2*)(base + 10240 + off + 2 * r2);
  o.sc = *(const f32x2*)(base + 12288 + (off >> 5));
}
#define LO2(x) ((f32x2){(x)[0], (x)[1]})
#define HI2(x) ((f32x2){(x)[2], (x)[3]})
DEVI float scan_step(f32x2 (&S)[4], const StepOps& o, float vrow) {
  f32x2 p0 = S[0] * LO2(o.a0), p1 = S[1] * HI2(o.a0);
  f32x2 q0 = S[0] * LO2(o.r0), q1 = S[1] * HI2(o.r0);
  p0 = S[2] * LO2(o.a1) + p0; p1 = S[3] * HI2(o.a1) + p1;
  q0 = S[2] * LO2(o.r1) + q0; q1 = S[3] * HI2(o.r1) + q1;
  p0 += p1; q0 += q1;
  float sa = p0.x + p0.y, yy = q0.x + q0.y;
  sa += dppf<0xB1>(sa); yy += dppf<0xB1>(yy);
  sa += dppf<0x4E>(sa); yy += dppf<0x4E>(yy);
  sa += dppf<0x141>(sa); yy += dppf<0x141>(yy);
  const f32x2 sa2 = {sa, sa}, v2 = {vrow, vrow};
  S[0] = S[0] * LO2(o.w0) + (sa2 * LO2(o.b0) + v2 * LO2(o.k0));
  S[1] = S[1] * HI2(o.w0) + (sa2 * HI2(o.b0) + v2 * HI2(o.k0));
  S[2] = S[2] * LO2(o.w1) + (sa2 * LO2(o.b1) + v2 * LO2(o.k1));
  S[3] = S[3] * HI2(o.w1) + (sa2 * HI2(o.b1) + v2 * HI2(o.k1));
  return yy + sa * o.sc.x + vrow * o.sc.y;
}
DEVI void unpack8(const uint4& u, float (&v)[8]) {
  v[0] = bflo(u.x); v[1] = bfhi(u.x); v[2] = bflo(u.y); v[3] = bfhi(u.y); v[4] = bflo(u.z); v[5] = bfhi(u.z); v[6] = bflo(u.w); v[7] = bfhi(u.w);
}
DEVI void scan_phase(KParams& p, int j, unsigned char* smem, int wave_s) {
  bf16_t* R = (bf16_t*)(p.ws + WS_R);
  const bf16_t* Fr = R; const bf16_t* Fk = R + (size_t)T * 1024; const bf16_t* Fv = R + (size_t)2 * T * 1024; const bf16_t* Fl = R + R_FL;
  const bf16_t* VF = (const bf16_t*)(p.ws + WS_VF);
  float* sm = (float*)smem;
  float* cst = sm;
  float* OPS = cst + 512;
  float* YB = OPS + 2 * OPS_STRIDE;
  float* RKB = YB + 4096;
  float* XS = RKB + 64;
  uint4* BL = (uint4*)(XS + 6144);
  const int tid = opaque_tid(wave_s);
  const int wave = tid >> 6, lane = tid & 63;
  for (int item = blockIdx.x; item < 256; item += gridDim.x) {
    const int b = item & 7, d = (item >> 3) & 1, h = item >> 4;
    bf16_t* Z = (bf16_t*)(p.ws + (d ? WS_N2 : WS_N1));
#define CHUNK_BASE(ci_) ((ci_) < 8 ? (TL + b * 256 + (d ? (7 - (ci_)) : (ci_)) * 32) : (b * 4096 + (d ? (127 - ((ci_) - 8)) : ((ci_) - 8)) * 32))
    __syncthreads();
    if (tid < 64) {
      const int c = h * 64 + tid;
      cst[tid] = p.in[18][(j * 2 + d) * 1024 + c]; cst[64 + tid] = p.in[21][(j * 2 + d) * 1024 + c];
      cst[128 + tid] = p.in[15][j * 1024 + c]; cst[192 + tid] = p.in[16][j * 1024 + c]; cst[256 + tid] = p.in[17][j * 1024 + c];
      cst[320 + tid] = p.in[26][(j * 2 + d) * 1024 + c]; cst[384 + tid] = p.in[27][(j * 2 + d) * 1024 + c];
      cst[448 + tid] = j > 0 ? p.in[28][(j - 1) * 1024 + c] : 0.f;
    }
    {
      const int fr = lane & 15, fq = lane >> 4, ct = wave >> 1, ks = wave & 1;
      const float* a2s = p.in[23] + ((size_t)(j * 2 + d) * 64) * 1024 + h * 64 + fr;
      uint4 o;
      { const size_t ro = (size_t)(ks * 32 + fq * 8) * 1024 + ct * 16;
        o.x = cvt_pk_bf16(a2s[ro], a2s[ro + 1024]); o.y = cvt_pk_bf16(a2s[ro + 2048], a2s[ro + 3072]);
        o.z = cvt_pk_bf16(a2s[ro + 4096], a2s[ro + 5120]); o.w = cvt_pk_bf16(a2s[ro + 6144], a2s[ro + 7168]); }
      BL[wave * 64 + lane] = o;
      if (wave < 4) {
        uint4 z = {0, 0, 0, 0};
        if (j > 0) {
          const float* v2s = p.in[30] + (size_t)(j - 1) * 32 * 1024 + h * 64 + fr;
          const size_t ro = (size_t)(fq * 8) * 1024 + wave * 16;
          z.x = cvt_pk_bf16(v2s[ro], v2s[ro + 1024]); z.y = cvt_pk_bf16(v2s[ro + 2048], v2s[ro + 3072]);
          z.z = cvt_pk_bf16(v2s[ro + 4096], v2s[ro + 5120]); z.w = cvt_pk_bf16(v2s[ro + 6144], v2s[ro + 7168]);
        }
        BL[(8 + wave) * 64 + lane] = z;
      }
    }
    __syncthreads();
    if (wave >= 4) {
      const int pw = wave - 4, fr = lane & 15, fq = lane >> 4, tkl = lane >> 3, c8 = (lane & 7) * 8;
      float* X = XS + pw * 1536;
      union BF { unsigned u[4]; bf16x8 v; };
      BF bw2[4][2];
      {
        const float* w2s = p.in[20] + ((size_t)(j * 2 + d) * 64) * 1024 + h * 64 + fr;
#pragma unroll
        for (int ct = 0; ct < 4; ++ct)
#pragma unroll
          for (int ks = 0; ks < 2; ++ks)
#pragma unroll
            for (int q = 0; q < 4; ++q) {
              const size_t ro = (size_t)(ks * 32 + fq * 8 + 2 * q) * 1024 + ct * 16;
              bw2[ct][ks].u[q] = cvt_pk_bf16(w2s[ro], w2s[ro + 1024]);
            }
      }
      struct PrepRegs { uint4 ur, uk, uv, uvf; bf16x8 alw[2], ala[2], alv; };
#define PREP_LOAD(N_, nc_) do { const int gb_ = CHUNK_BASE(nc_); const size_t tokA_ = (size_t)gb_ + pw * 8 + (fr & 7), gt_ = (size_t)gb_ + pw * 8 + tkl; \
        N_.ur = *(const uint4*)(Fr + gt_ * 1024 + h * 64 + c8); N_.uk = *(const uint4*)(Fk + gt_ * 1024 + h * 64 + c8); N_.uv = *(const uint4*)(Fv + gt_ * 1024 + h * 64 + c8); \
        N_.uvf = (uint4){0, 0, 0, 0}; if (j > 0) N_.uvf = *(const uint4*)(VF + gt_ * 1024 + h * 64 + c8); \
        for (int ks = 0; ks < 2; ++ks) { N_.alw[ks] = *(const bf16x8*)(Fl + tokA_ * 768 + d * 128 + ks * 32 + fq * 8); N_.ala[ks] = *(const bf16x8*)(Fl + tokA_ * 768 + d * 128 + 64 + ks * 32 + fq * 8); } \
        N_.alv = N_.alw[0]; if (j > 0) N_.alv = *(const bf16x8*)(Fl + tokA_ * 768 + 672 + fq * 8); } while (0)
      PrepRegs NX;
      PREP_LOAD(NX, 0);
#pragma unroll 1
      for (int c = -1; c < 136; ++c) {
        if (c >= 1) {
          const int pc = c - 1, buf = pc & 1, tr = pw * 8 + tkl;
          const float* O = OPS + buf * OPS_STRIDE;
          const size_t gt = (size_t)CHUNK_BASE(pc) + tr;
          const f32x4 ya = *(const f32x4*)(YB + buf * 2048 + tr * 64 + c8), yb = *(const f32x4*)(YB + buf * 2048 + tr * 64 + c8 + 4);
          const float mu = red8((ya[0] + ya[1] + ya[2] + ya[3]) + (yb[0] + yb[1] + yb[2] + yb[3])) * (1.f / 64.f);
          const f32x4 da = ya - mu, db = yb - mu;
          const float var = red8((da[0] * da[0] + da[1] * da[1] + da[2] * da[2] + da[3] * da[3]) + (db[0] * db[0] + db[1] * db[1] + db[2] * db[2] + db[3] * db[3])) * (1.f / 64.f);
          const float rs = __builtin_amdgcn_rsqf(var + 64e-5f);
          const float rk = RKB[buf * 32 + tr];
          const f32x4 va = *(const f32x4*)(O + 10240 + tr * 64 + c8), vb = *(const f32x4*)(O + 10240 + tr * 64 + c8 + 4);
          f32x4 oa, ob;
#pragma unroll
          for (int e = 0; e < 4; ++e) {
            oa[e] = da[e] * rs * cst[320 + c8 + e] + cst[384 + c8 + e] + rk * va[e];
            ob[e] = db[e] * rs * cst[320 + c8 + 4 + e] + cst[384 + c8 + 4 + e] + rk * vb[e];
          }
          *(uint4*)(Z + gt * 1024 + h * 64 + c8) = pack8(oa, ob);
        }
        if (c + 1 < 136) {
          const int nc = c + 1, buf = nc & 1, tr = pw * 8 + tkl;
          float* O = OPS + buf * OPS_STRIDE;
          const PrepRegs PC = NX;
          if (nc + 1 < 136) PREP_LOAD(NX, nc + 1);
          const uint4 ur = PC.ur, uk = PC.uk, uv = PC.uv, uvf = PC.uvf;
          bf16x8 alw[2], ala[2], alv;
          alw[0] = PC.alw[0]; alw[1] = PC.alw[1]; ala[0] = PC.ala[0]; ala[1] = PC.ala[1]; alv = PC.alv;
#pragma unroll
          for (int ct = 0; ct < 4; ++ct) {
            f32x4 cD = {0.f, 0.f, 0.f, 0.f}, cA = {0.f, 0.f, 0.f, 0.f}, cV = {0.f, 0.f, 0.f, 0.f};
            cD = __builtin_amdgcn_mfma_f32_16x16x32_bf16(alw[0], bw2[ct][0].v, cD, 0, 0, 0);
            cD = __builtin_amdgcn_mfma_f32_16x16x32_bf16(alw[1], bw2[ct][1].v, cD, 0, 0, 0);
            { BF t0, t1; *(uint4*)t0.u = BL[(ct * 2 + 0) * 64 + lane]; *(uint4*)t1.u = BL[(ct * 2 + 1) * 64 + lane];
              cA = __builtin_amdgcn_mfma_f32_16x16x32_bf16(ala[0], t0.v, cA, 0, 0, 0);
              cA = __builtin_amdgcn_mfma_f32_16x16x32_bf16(ala[1], t1.v, cA, 0, 0, 0); }
            if (j > 0) { BF t2; *(uint4*)t2.u = BL[(8 + ct) * 64 + lane]; cV = __builtin_amdgcn_mfma_f32_16x16x32_bf16(alv, t2.v, cV, 0, 0, 0); }
            if (fq < 2) {
#pragma unroll
              for (int q = 0; q < 4; ++q) {
                X[(fq * 4 + q) * 64 + ct * 16 + fr] = cD[q];
                X[512 + (fq * 4 + q) * 64 + ct * 16 + fr] = cA[q];
                X[1024 + (fq * 4 + q) * 64 + ct * 16 + fr] = cV[q];
              }
            }
          }
          asm volatile("s_waitcnt lgkmcnt(0)" ::: "memory");
          float ssq = 0.f, rks = 0.f, brs = 0.f, krs = 0.f;
          {
            float kr[8]; unpack8(uk, kr);
#pragma unroll
            for (int e = 0; e < 8; ++e) { const float t = kr[e] * cst[128 + c8 + e]; ssq += t * t; }
          }
          ssq = red8(ssq);
          const float kinv = __builtin_amdgcn_rcpf(fmaxf(sqrtf(ssq), 1e-12f));
          float* q = O + tr * 64 + c8;
#pragma unroll
          for (int hh = 0; hh < 2; ++hh) {
            const int co = c8 + hh * 4;
            const f32x4 dl = *(const f32x4*)(X + tkl * 64 + co), ap = *(const f32x4*)(X + 512 + tkl * 64 + co), vr = *(const f32x4*)(X + 1024 + tkl * 64 + co);
            const unsigned r0 = hh ? ur.z : ur.x, r1 = hh ? ur.w : ur.y, k0 = hh ? uk.z : uk.x, k1 = hh ? uk.w : uk.y;
            const unsigned v0 = hh ? uv.z : uv.x, v1 = hh ? uv.w : uv.y, f0 = hh ? uvf.z : uvf.x, f1 = hh ? uvf.w : uvf.y;
            const f32x4 rr = {bflo(r0), bfhi(r0), bflo(r1), bfhi(r1)}, kr = {bflo(k0), bfhi(k0), bflo(k1), bfhi(k1)};
            f32x4 vv = {bflo(v0), bfhi(v0), bflo(v1), bfhi(v1)};
            const f32x4 vf = {bflo(f0), bfhi(f0), bflo(f1), bfhi(f1)};
            f32x4 wd, kd, aa, bb, wr4;
#pragma unroll
            for (int e = 0; e < 4; ++e) {
              const float z = -(cst[co + e] + dl[e]);
              const float sp = fmaxf(z, 0.f) + __logf(1.f + __expf(-fabsf(z)));
              const float w = -sp - 0.5f;
              wd[e] = __expf(-__expf(w));
              const float a = __builtin_amdgcn_rcpf(1.f + __expf(-(cst[64 + co + e] + ap[e])));
              const float kk = kr[e] * cst[128 + co + e] * kinv;
              kd[e] = kr[e] * (1.f + (a - 1.f) * cst[192 + co + e]);
              aa[e] = -kk; bb[e] = kk * a;
              if (j > 0) vv[e] = vv[e] + (vf[e] - vv[e]) * __builtin_amdgcn_rcpf(1.f + __expf(-(cst[448 + co + e] + vr[e])));
              rks += rr[e] * kd[e] * cst[256 + co + e];
              wr4[e] = wd[e] * rr[e]; brs += bb[e] * rr[e]; krs += kd[e] * rr[e];
            }
            *(f32x4*)(q + hh * 4) = wd; *(f32x4*)(q + 2048 + hh * 4) = kd; *(f32x4*)(q + 4096 + hh * 4) = aa;
            *(f32x4*)(q + 6144 + hh * 4) = bb; *(f32x4*)(q + 8192 + hh * 4) = wr4; *(f32x4*)(q + 10240 + hh * 4) = vv;
          }
          rks = red8(rks); brs = red8(brs); krs = red8(krs);
          if ((lane & 7) == 0) { RKB[buf * 32 + tr] = rks; *(f32x2*)(O + 12288 + tr * 2) = (f32x2){brs, krs}; }
        }
        __syncthreads();
      }
      {
        const int pc = 135, buf = pc & 1, tr = pw * 8 + tkl;
        const float* O = OPS + buf * OPS_STRIDE;
        const size_t gt = (size_t)CHUNK_BASE(pc) + tr;
        const f32x4 ya = *(const f32x4*)(YB + buf * 2048 + tr * 64 + c8), yb = *(const f32x4*)(YB + buf * 2048 + tr * 64 + c8 + 4);
        const float mu = red8((ya[0] + ya[1] + ya[2] + ya[3]) + (yb[0] + yb[1] + yb[2] + yb[3])) * (1.f / 64.f);
        const f32x4 da = ya - mu, db = yb - mu;
        const float var = red8((da[0] * da[0] + da[1] * da[1] + da[2] * da[2] + da[3] * da[3]) + (db[0] * db[0] + db[1] * db[1] + db[2] * db[2] + db[3] * db[3])) * (1.f / 64.f);
        const float rs = __builtin_amdgcn_rsqf(var + 64e-5f);
        const float rk = RKB[buf * 32 + tr];
        const f32x4 va = *(const f32x4*)(O + 10240 + tr * 64 + c8), vb = *(const f32x4*)(O + 10240 + tr * 64 + c8 + 4);
        f32x4 oa, ob;
#pragma unroll
        for (int e = 0; e < 4; ++e) {
          oa[e] = da[e] * rs * cst[320 + c8 + e] + cst[384 + c8 + e] + rk * va[e];
          ob[e] = db[e] * rs * cst[320 + c8 + 4 + e] + cst[384 + c8 + 4 + e] + rk * vb[e];
        }
        *(uint4*)(Z + gt * 1024 + h * 64 + c8) = pack8(oa, ob);
      }
    } else {
      const int r2 = tid >> 3, kq = tid & 7;
      f32x2 S0[4], S1[4];
#pragma unroll
      for (int i = 0; i < 4; ++i) { S0[i] = (f32x2){0.f, 0.f}; S1[i] = (f32x2){0.f, 0.f}; }
      __syncthreads();
      __builtin_amdgcn_s_setprio(3);
#pragma unroll 1
      for (int c = 0; c < 136; ++c) {
        const float* base = OPS + (c & 1) * OPS_STRIDE;
        float* Y = YB + (c & 1) * 2048;
        const int o0 = d ? 31 * 64 : 0, dstep = d ? -64 : 64;
        StepOps A, B;
        scan_load(A, base, o0, kq, r2);
#pragma unroll 1
        for (int s = 0; s < 32; s += 2) {
          const int oa = o0 + s * dstep, ob = oa + dstep;
          scan_load(B, base, ob, kq, r2);
          { const float y0 = scan_step(S0, A, A.v.x), y1 = scan_step(S1, A, A.v.y);
            if (kq == 0) *(f32x2*)(Y + oa + 2 * r2) = (f32x2){y0, y1}; }
          scan_load(A, base, ob + dstep, kq, r2);
          { const float y0 = scan_step(S0, B, B.v.x), y1 = scan_step(S1, B, B.v.y);
            if (kq == 0) *(f32x2*)(Y + ob + 2 * r2) = (f32x2){y0, y1}; }
        }
        __syncthreads();
      }
      __builtin_amdgcn_s_setprio(0);
    }
  }
}

DEVI bool run_phase(KParams& p, int ph, unsigned char* smem, int wave_s) {
  unsigned char* ws = p.ws;
  float* MOD = (float*)(ws + WS_MOD);
  float* XC = (float*)(ws + WS_XC);
  bf16_t* WB = (bf16_t*)(ws + WS_WB);
  bf16_t* N1 = (bf16_t*)(ws + WS_N1); bf16_t* N2 = (bf16_t*)(ws + WS_N2); bf16_t* VF = (bf16_t*)(ws + WS_VF);
  bf16_t* R = (bf16_t*)(ws + WS_R);
  if (ph == 0) {
    for (int job = blockIdx.x; job < 288; job += gridDim.x) mod_job(p, job, (float*)smem, wave_s);
    rope_table(p, wave_s);
    conv_layer(p, 0, smem, wave_s);
    return true;
  }
  if (ph == 1) {
    RowPass a{}; a.xl = p.in[0]; a.xc = p.in[2]; a.ol = nullptr; a.oc = nullptr; a.y = nullptr;
    a.n = N1; a.gpre = p.in[6]; a.modn = MOD; a.mshift = 0; a.mscale = 1; a.tmax = T;
    rowpass(a, wave_s); return true;
  }
  const int i = (ph - 2) / 12, s = (ph - 2) % 12, kind = i % 3, j = i / 3;
  const float* ng = p.in[6] + (size_t)i * 6 * 1024;
  const float* modi = MOD + (size_t)i * 9 * 9216;
  int gsel = -1;
  GemmArgs g{}; g.M = T;
  const bool noctx = (i == 3 && s >= 6);
  if (noctx) g.M = TL;
  bf16_t* SLAB = R + (size_t)T * FF;
  EpiBf16 eb{}; EpiSwiglu es{}; EpiFeat ef{}; EpiReadout er0{}, er1{};
  GemmArgs g2{};
  switch (s) {
    case 0: case 9: { const int h = s == 9; g.A1 = N1; g.A2 = N1; g.ksplit = 1024; g.lda = 1024; g.Bt = WB + (h ? WB_UP1 : WB_UP0); g.N = 5632; g.K = 1024; es.H = R; gsel = 0; break; }
    case 1: case 10: { const int h = s == 10; g.A1 = R; g.A2 = R; g.ksplit = FF; g.lda = FF; g.Bt = WB + (h ? WB_DN1 : WB_DN0); g.N = 1024; g.K = FF; eb.O = N2; eb.ldc = 1024; eb.slab = SLAB; g.split = noctx ? 0 : 3; gsel = 1; break; }
    case 2: case 8: case 11: {
      RowPass a{};
      const bool first = (i == 0 && s == 2);
      a.xl = first ? p.in[0] : p.out; a.xc = first ? p.in[2] : XC; a.ol = p.out; a.oc = XC;
      a.y = N2; a.modg = modi; a.tmax = noctx ? TL : T; a.yslab = SLAB; a.nslab = (s == 8) ? 2 : 3;
      if (s == 2) { a.gpost = ng + 1024; a.mgate = 2; a.coef = 0.5f; a.n = N1; a.gpre = ng + 2 * 1024; a.modn = modi; a.mshift = 3; a.mscale = 4; }
      else if (s == 8) { a.gpost = ng + 3 * 1024; a.mgate = 5; a.coef = 1.f; a.n = N1; a.gpre = ng + 4 * 1024; a.modn = modi; a.mshift = 6; a.mscale = 7; }
      else { a.gpost = ng + 5 * 1024; a.mgate = 8; a.coef = 0.5f;
        if (i < 3) { a.n = N1; a.gpre = ng + 6 * 1024; a.modn = modi + 9 * 9216; a.mshift = 0; a.mscale = 1; }
        else { a.n = nullptr; a.tmax = TL; } }
      rowpass(a, wave_s);
      if (s == 11 && i < 3) conv_layer(p, i + 1, smem, wave_s);
      return true;
    }
    case 3:
      if (kind == 0) { shift_phase(N1, N2, wave_s); return true; }
      g.A1 = N1; g.A2 = N1; g.ksplit = 1024; g.lda = 1024; g.Bt = WB + WB_MIX; g.N = 1536; g.K = 1024; eb.O = R; eb.ldc = 1536; gsel = 1; break;
    case 4:
      if (kind == 0) { g.A1 = N1; g.A2 = N2; g.ksplit = 1024; g.lda = 1024; g.Bt = WB + WB_MIX; g.N = 3840; g.K = 2048; ef.Fr = R; ef.Fl = R + R_FL; ef.VF = VF; ef.dup_v = (j == 0); gsel = 2; break; }
      attn_post(p, kind == 1 ? 0 : 1, smem, wave_s); return true;
    case 5:
      if (kind == 0) scan_phase(p, j, smem, wave_s); else attn_core(p, kind == 1 ? 0 : 1, smem, wave_s);
      return true;
    case 6:
      if (kind != 0) return false;
      g.A1 = R + R_FL + 256; g.A2 = g.A1; g.ksplit = 256; g.lda = 768; g.Bt = WB + WB_G2T; g.N = 1024; g.K = 256;
      g2 = g; g2.A1 = R + R_FL + 512; g2.A2 = g2.A1; g2.Bt = WB + WB_G2T + (size_t)1024 * 256;
      er0.O = R; er0.Z = N1; er0.add = 0; er1.O = R; er1.Z = N2; er1.add = 1; gsel = 3; break;
    case 7:
      g.A1 = R; g.A2 = R; g.ksplit = 1024; g.lda = 1024; g.Bt = WB + WB_WO; g.N = 1024; g.K = 1024; eb.O = N2; eb.ldc = 1024; eb.slab = SLAB; g.split = noctx ? 0 : 2; gsel = 1; break;
  }
  if (gsel == 0) gemm_phase(g, es, smem, wave_s);
  else if (gsel == 1) gemm_phase(g, eb, smem, wave_s);
  else if (gsel == 2) gemm_phase(g, ef, smem, wave_s);
  else if (gsel == 3) { gemm_phase(g, er0, smem, wave_s); gemm_phase(g2, er1, smem, wave_s); }
  return true;
}


#define XB_TMO      128
#define XB_XCNT(j)  (256  + 64 * (j))
#define XB_XSUB(j)  (1280 + 64 * (j))
#define XB_XGEN(j)  (2304 + 64 * (j))
#define XB_TOP      3328
#define XB_TOPGEN   3392
#define XCD_BAR_WORDS 3456
#define XB_SPIN_CAP (1u << 22)
#define LAS __attribute__((address_space(3)))
DEVI unsigned xb_ld(unsigned* p)              { return __hip_atomic_load(p, __ATOMIC_RELAXED, __HIP_MEMORY_SCOPE_AGENT); }
DEVI unsigned xb_add(unsigned* p, unsigned v) { return __hip_atomic_fetch_add(p, v, __ATOMIC_RELAXED, __HIP_MEMORY_SCOPE_AGENT); }
DEVI unsigned xb_xcc_id() { return (unsigned)__builtin_amdgcn_s_getreg((3 << 11) | 20) & 0xFu; }
#define XB_SPIN(cond, bar) do { unsigned _sp = 0; while (cond) { __builtin_amdgcn_s_sleep(1); \
    if ((++_sp & 255u) == 0u) { if (xb_ld(&(bar)[XB_TMO])) break; if (_sp > XB_SPIN_CAP) { atomicAdd(&(bar)[XB_TMO], 1u); break; } } } } while (0)
struct XcdBarrier { unsigned* bar; unsigned x; volatile LAS unsigned* st; };
DEVI void xcd_barrier_complete(unsigned* bar, unsigned x, unsigned& nloc, unsigned& nx) {
  const unsigned G = gridDim.x;
  unsigned sum, cnt, mine, sp = 0u;
  for (;;) {
    sum = 0u; cnt = 0u; mine = 0u;
#pragma unroll
    for (unsigned j = 0; j < 16; ++j) { const unsigned c = xb_ld(&bar[XB_XCNT(j)]); sum += c; cnt += (c > 0u) ? 1u : 0u; mine = (j == x) ? c : mine; }
    if (sum == G) break;
    __builtin_amdgcn_s_sleep(1);
    if ((++sp & 255u) == 0u) { if (xb_ld(&bar[XB_TMO])) break; if (sp > XB_SPIN_CAP) { atomicAdd(&bar[XB_TMO], 1u); break; } }
  }
  nloc = mine > 0u ? mine : 1u; nx = cnt > 0u ? cnt : 1u;
}
DEVI void xcd_barrier(const XcdBarrier& b, bool t0) {
  asm volatile("s_waitcnt vmcnt(0)" ::: "memory");
  __syncthreads();
  if (t0) {
    unsigned* bar = b.bar;
    __builtin_amdgcn_s_waitcnt(0);
    unsigned nloc = b.st[0], nx = b.st[1];
    if (nloc == 0u) { xcd_barrier_complete(bar, b.x, nloc, nx); b.st[0] = nloc; b.st[1] = nx; }
    const unsigned old = xb_add(&bar[XB_XSUB(b.x)], 1u);
    const unsigned gen = old / nloc;
    if (old + 1u == (gen + 1u) * nloc) {
      __builtin_amdgcn_fence(__ATOMIC_RELEASE, "agent");
      asm volatile("s_waitcnt vmcnt(0)" ::: "memory");
      const unsigned og = xb_add(&bar[XB_TOP], 1u);
      const unsigned tg = og / nx;
      if (og + 1u == (tg + 1u) * nx) xb_add(&bar[XB_TOPGEN], 1u);
      else XB_SPIN(xb_ld(&bar[XB_TOPGEN]) == tg, bar);
      __builtin_amdgcn_fence(__ATOMIC_ACQUIRE, "agent");
      xb_add(&bar[XB_XGEN(b.x)], 1u);
      asm volatile("s_waitcnt vmcnt(0)" ::: "memory");
    } else {
      XB_SPIN(xb_ld(&bar[XB_XGEN(b.x)]) == gen, bar);
      __builtin_amdgcn_fence(__ATOMIC_ACQUIRE, "agent");
      asm volatile("s_waitcnt vmcnt(0)" ::: "memory");
    }
  }
  __syncthreads();
}

constexpr int LDS_BYTES = 155648;
constexpr size_t WS_BAR = 3 * MiB / 2;
__global__ void __launch_bounds__(NT) mega(Params p) {
  extern __shared__ __attribute__((aligned(16))) unsigned char smem[];
  cg::grid_group grid = cg::this_grid();
  const int wave_s = __builtin_amdgcn_readfirstlane((int)(threadIdx.x >> 6));
  const int ph_lo = p.ph_lo, ph_hi = p.ph_hi;
  __shared__ uint4 xb_words;
  XcdBarrier xb; xb.bar = (unsigned*)(p.ws + WS_BAR); xb.x = xb_xcc_id(); xb.st = (volatile LAS unsigned*)&xb_words;
  if (ph_hi - ph_lo > 1) {
    const bool t0 = opaque_tid(wave_s) == 0;
    if (t0) { xb_words = make_uint4(0u, 0u, 0u, 0u); (void)xb_add(&xb.bar[XB_XCNT(xb.x)], 1u); }
    __syncthreads();
  }
  for (int ph = ph_lo; ph < ph_hi; ++ph) {
    KParams* pp = (KParams*)__builtin_amdgcn_kernarg_segment_ptr();
    asm volatile("" : "+s"(pp));
    const bool ran = run_phase(*pp, ph, smem, wave_s);
    if (ran && ph + 1 < ph_hi) {
      if (ph_lo > 0x3fffffff) grid.sync();
      xcd_barrier(xb, opaque_tid(wave_s) == 0);
    }
  }
}

extern "C" void kernel_launch(void* const* d_in, const int* in_sizes, int n_in, void* d_out, int out_size, void* d_ws, size_t ws_size, hipStream_t stream) {
  static int grid_blocks = 0;
  if (!grid_blocks) {
    int dev = 0, cus = 0, per_cu = 0;
    hipGetDevice(&dev);
    hipDeviceGetAttribute(&cus, hipDeviceAttributeMultiprocessorCount, dev);
    hipFuncSetAttribute((const void*)mega, hipFuncAttributeMaxDynamicSharedMemorySize, LDS_BYTES);
    hipOccupancyMaxActiveBlocksPerMultiprocessor(&per_cu, (const void*)mega, NT, LDS_BYTES);
    if (per_cu < 1) per_cu = 1;
    if (per_cu > 1) per_cu = 1;
    grid_blocks = cus * per_cu;
    if (ws_size < WS_END || n_in != 42) fprintf(stderr, "kernel_launch: unexpected ws_size %zu / n_in %d\n", ws_size, n_in);
  }
  Params p{};
  for (int i = 0; i < 42; ++i) p.in[i] = (const float*)d_in[i];
  p.out = (float*)d_out; p.ws = (unsigned char*)d_ws;
  const int NPH = 2 + 4 * 12;
#if ONE_LAUNCH
  if (hipMemsetAsync((char*)d_ws + WS_BAR, 0, XCD_BAR_WORDS * sizeof(unsigned), stream) != hipSuccess) fprintf(stderr, "memset of barrier words failed\n");
  p.ph_lo = 0; p.ph_hi = NPH;
  void* args[] = {&p};
  hipError_t e = hipLaunchCooperativeKernel((const void*)mega, dim3(grid_blocks), dim3(NT), args, LDS_BYTES, stream);
  if (e != hipSuccess) fprintf(stderr, "cooperative launch failed: %s (grid %d)\n", hipGetErrorString(e), grid_blocks);
#else
  for (int ph = 0; ph < NPH; ++ph) {
    p.ph_lo = ph; p.ph_hi = ph + 1;
    hipLaunchKernelGGL(mega, dim3(grid_blocks), dim3(NT), LDS_BYTES, stream, p);
  }
#endif
}
```

```cpp
#include <hip/hip_runtime.h>
#include <hip/hip_cooperative_groups.h>
#include <cstdint>
#include <cstdio>
namespace cg = cooperative_groups;

#define DEVI __device__ __forceinline__
typedef unsigned short bf16_t;
typedef short bf16x8 __attribute__((ext_vector_type(8)));
typedef short bf16x4 __attribute__((ext_vector_type(4)));
typedef float f32x4 __attribute__((ext_vector_type(4)));
typedef float f32x16 __attribute__((ext_vector_type(16)));

#ifndef ONE_LAUNCH
#define ONE_LAUNCH 1
#endif

constexpr int D = 1024, TL = 32768, TCX = 2048, T = TL + TCX, FF = 2816, LK = 4352;
constexpr int NT = 512;
constexpr size_t MiB = 1u << 20;
constexpr size_t WS_MOD = 0;
constexpr size_t WS_ROPE = 2 * MiB;
constexpr size_t WS_XC = 4 * MiB;
constexpr size_t WS_WB = 12 * MiB;
constexpr size_t WS_N1 = 64 * MiB;
constexpr size_t WS_N2 = 132 * MiB;
constexpr size_t WS_VF = 200 * MiB;
constexpr size_t WS_R = 268 * MiB;
constexpr size_t WS_END = 524 * MiB;
constexpr size_t WB_UP0 = 0, WB_UP1 = (size_t)5632 * 1024, WB_DN0 = 2 * WB_UP1, WB_DN1 = WB_DN0 + (size_t)1024 * 2816,
                 WB_MIX = WB_DN1 + (size_t)1024 * 2816, WB_WO = WB_MIX + (size_t)3840 * 2048, WB_G2T = WB_WO + (size_t)1024 * 1024;
constexpr size_t R_FL = (size_t)3 * T * 1024;
constexpr size_t R_QB = (size_t)T * 1536;
constexpr size_t R_KB = R_QB + (size_t)T * 1024;
constexpr size_t R_VT = R_KB + (size_t)8 * 4 * LK * 64;

struct Params {
  const float* in[42];
  float* out;
  unsigned char* ws;
  int ph_lo, ph_hi;
};

DEVI unsigned cvt_pk_bf16(float lo, float hi) { unsigned r; asm("v_cvt_pk_bf16_f32 %0, %1, %2" : "=v"(r) : "v"(lo), "v"(hi)); return r; }
DEVI float bflo(unsigned u) { return __uint_as_float(u << 16); }
DEVI float bfhi(unsigned u) { return __uint_as_float(u & 0xffff0000u); }
DEVI float rdlane(float v, int l) { return __builtin_bit_cast(float, __builtin_amdgcn_readlane(__builtin_bit_cast(int, v), l)); }
DEVI float xor32f(float v, int lane) { return __builtin_bit_cast(float, __builtin_amdgcn_ds_bpermute((lane ^ 32) << 2, __builtin_bit_cast(int, v))); }
template <int CTRL> DEVI float dppf(float v) { return __builtin_bit_cast(float, __builtin_amdgcn_update_dpp(0, __builtin_bit_cast(int, v), CTRL, 0xf, 0xf, true)); }
DEVI float red8(float v) { v += dppf<0xB1>(v); v += dppf<0x4E>(v); v += dppf<0x141>(v); return v; }
DEVI float red16(float v) { v = red8(v); v += dppf<0x140>(v); return v; }
DEVI float wave_sum(float v) { v = red16(v); return (rdlane(v, 0) + rdlane(v, 16)) + (rdlane(v, 32) + rdlane(v, 48)); }
typedef const __attribute__((address_space(4))) Params KParams;
DEVI int opaque_tid(int wave_s) { int t; asm volatile("v_mbcnt_lo_u32_b32 %0, -1, 0\n\tv_mbcnt_hi_u32_b32 %0, -1, %0\n\tv_lshl_add_u32 %0, %1, 6, %0" : "=&v"(t) : "s"(wave_s)); return t; }
DEVI float sigmoidf_(float x) { return __builtin_amdgcn_rcpf(1.f + __expf(-x)); }
DEVI float tanhf_(float x) { return 1.f - 2.f * __builtin_amdgcn_rcpf(1.f + __expf(2.f * x)); }

constexpr int BM = 256, BK = 64, HALF = 128, NXCD = 8, WGM = 8, HT = HALF * BK;
struct GemmArgs { const bf16_t* A1; const bf16_t* A2; int ksplit; int lda; const bf16_t* Bt; int M, N, K; int split; };

DEVI int lds_byte(int r, int c) { int st = (r >> 4) * 2 + (c >> 5), rr = r & 15, cc = c & 31, ob = rr * 64 + cc * 2; return st * 1024 + (ob ^ (((ob >> 9) & 1) << 5)); }
DEVI void stage_rc(int b, int& R, int& C) { int st = b / 1024, sb = b % 1024, swz = sb ^ (((sb >> 9) & 1) << 5); R = (st >> 1) * 16 + swz / 64; C = (st & 1) * 32 + (swz % 64) / 2; }

template <class Epi>
DEVI void gemm_phase(const GemmArgs& g, const Epi& epi, unsigned char* smem, int wave_s) {
  bf16_t* shm = (bf16_t*)smem;
#define SA(b, h) (shm + ((b) * 2 + (h)) * HT)
#define SB(b, h) (shm + (4 + (b) * 2 + (h)) * HT)
#define STAGE_B(P, br, kt) do { const char* _g = (const char*)(g.Bt + (size_t)(br) * K + koff + (size_t)(kt) * BK); \
    __builtin_amdgcn_global_load_lds((const unsigned*)(_g + ob0), (unsigned*)((char*)(P) + sb0), 16, 0, 0); \
    __builtin_amdgcn_global_load_lds((const unsigned*)(_g + ob1), (unsigned*)((char*)(P) + sb1), 16, 0, 0); } while (0)
#define STAGE_A(P, br, kt) do { const int _k0 = koff + (kt) * BK; const char* _g = (const char*)((_k0 < g.ksplit ? g.A1 + _k0 : g.A2 + (_k0 - g.ksplit)) + (size_t)(br) * lda); \
    __builtin_amdgcn_global_load_lds((const unsigned*)(_g + oa0), (unsigned*)((char*)(P) + sb0), 16, 0, 0); \
    __builtin_amdgcn_global_load_lds((const unsigned*)(_g + oa1), (unsigned*)((char*)(P) + sb1), 16, 0, 0); } while (0)
#define LDA(dst, b, h) for (int m = 0; m < 4; ++m) for (int k = 0; k < 2; ++k) \
    dst[m][k] = *reinterpret_cast<const bf16x8*>((char*)SA(b, h) + lds_byte(wr * 64 + m * 16 + fr, k * 32 + fq * 8))
#define LDB(dst, b, h) for (int n = 0; n < 2; ++n) for (int k = 0; k < 2; ++k) \
    dst[n][k] = *reinterpret_cast<const bf16x8*>((char*)SB(b, h) + lds_byte(wc * 32 + n * 16 + fr, k * 32 + fq * 8))
#define MMA(ai, bj, At_, Bt_) do { __builtin_amdgcn_s_setprio(1); \
    for (int m = 0; m < 4; ++m) for (int n = 0; n < 2; ++n) for (int k = 0; k < 2; ++k) \
      acc[ai][bj][m][n] = __builtin_amdgcn_mfma_f32_16x16x32_bf16(Bt_[n][k], At_[m][k], acc[ai][bj][m][n], 0, 0, 0); \
    __builtin_amdgcn_s_setprio(0); } while (0)
#define WAIT_V(n) asm volatile("s_waitcnt vmcnt(" #n ")" ::: "memory")
#define WAIT_L(n) asm volatile("s_waitcnt lgkmcnt(" #n ")" ::: "memory")
#define BAR __builtin_amdgcn_s_barrier()
#define SCHED __builtin_amdgcn_sched_barrier(0)
  const int K = g.K, lda = g.lda;
  const int nM = (g.split ? TL : g.M) / BM, nN = g.N / BM, nwg = nM * nN;
  const int nsp = g.split, nitems = nwg + (TCX / BM) * nN * nsp;
  const int ktot = K / BK, kbase = nsp ? ((ktot / nsp) & ~1) : 0;
  int sb0, sb1, wr, wc, fr, fq;
  unsigned oa0, oa1, ob0, ob1;
#define COMPUTE_OFFS() do { int tid_ = opaque_tid(wave_s); \
    const int wid_ = tid_ >> 6, lane_ = tid_ & 63; wr = wid_ >> 2; wc = wid_ & 3; fr = lane_ & 15; fq = lane_ >> 4; \
    sb0 = tid_ * 16; sb1 = tid_ * 16 + 8192; \
    int sr0, sc0, sr1, sc1; stage_rc(sb0, sr0, sc0); stage_rc(sb1, sr1, sc1); \
    oa0 = (unsigned)(sr0 * lda + sc0) * 2u; oa1 = (unsigned)(sr1 * lda + sc1) * 2u; ob0 = (unsigned)(sr0 * K + sc0) * 2u; ob1 = (unsigned)(sr1 * K + sc1) * 2u; } while (0)
  COMPUTE_OFFS();
  int brow = 0, bcol = 0, koff = 0, nt = 0, ks = -1;
#define TILE_COORDS(L_) do { \
    if ((L_) < nwg) { \
      int wgid = (L_); \
      { int q = nwg / NXCD, r = nwg % NXCD, xcd = wgid % NXCD, off = wgid / NXCD; wgid = (xcd < r ? xcd * (q + 1) : r * (q + 1) + (xcd - r) * q) + off; } \
      const int nig = WGM * nN, gid = wgid / nig, fm = gid * WGM, gsz = min(nM - fm, WGM); \
      const int pm = fm + ((wgid % nig) % gsz), pn = (wgid % nig) / gsz; \
      brow = pm * BM; bcol = pn * BM; koff = 0; nt = K / BK; ks = -1; \
    } else { \
      const int e = (L_) - nwg; ks = e % nsp; const int r = e / nsp; const int pn = r % nN, pmc = r / nN; \
      brow = TL + pmc * BM; bcol = pn * BM; koff = ks * kbase * BK; nt = (ks < nsp - 1) ? kbase : ktot - kbase * (nsp - 1); \
    } } while (0)
#define FIRST4() do { STAGE_B(SB(0, 0), bcol, 0); STAGE_A(SA(0, 0), brow, 0); STAGE_B(SB(0, 1), bcol + HALF, 0); STAGE_A(SA(0, 1), brow + HALF, 0); } while (0)
  int L = blockIdx.x;
  bool have = L < nitems;
  if (have) { TILE_COORDS(L); FIRST4(); }
  while (have) {
    f32x4 acc[2][2][4][2] = {};
    bf16x8 At[4][2], B0[2][2], B1[2][2];
    WAIT_V(0);
    if (wr == 1) BAR;
    BAR;
    STAGE_B(SB(1, 0), bcol, 1); STAGE_A(SA(1, 0), brow, 1); STAGE_B(SB(1, 1), bcol + HALF, 1);
    WAIT_V(6); BAR;
    for (int t = 0; t < nt - 2; t += 2) {
      LDB(B0, 0, 0); SCHED; LDA(At, 0, 0); STAGE_A(SA(1, 1), brow + HALF, t + 1);
      WAIT_L(8); BAR; WAIT_L(0); MMA(0, 0, At, B0); BAR; SCHED;
      LDB(B1, 0, 1); STAGE_B(SB(0, 0), bcol, t + 2);
      BAR; WAIT_L(0); MMA(0, 1, At, B1); BAR;
      LDA(At, 0, 1); STAGE_A(SA(0, 0), brow, t + 2);
      BAR; WAIT_L(0); MMA(1, 0, At, B0); BAR; SCHED;
      STAGE_B(SB(0, 1), bcol + HALF, t + 2);
      WAIT_V(6); BAR; MMA(1, 1, At, B1); BAR;
      LDB(B0, 1, 0); SCHED; LDA(At, 1, 0); STAGE_A(SA(0, 1), brow + HALF, t + 2);
      WAIT_L(8); BAR; WAIT_L(0); MMA(0, 0, At, B0); BAR; SCHED;
      LDB(B1, 1, 1); STAGE_B(SB(1, 0), bcol, t + 3);
      BAR; WAIT_L(0); MMA(0, 1, At, B1); BAR;
      LDA(At, 1, 1); STAGE_A(SA(1, 0), brow, t + 3);
      BAR; WAIT_L(0); MMA(1, 0, At, B0); BAR; SCHED;
      STAGE_B(SB(1, 1), bcol + HALF, t + 3);
      WAIT_V(6); BAR; MMA(1, 1, At, B1); BAR;
    }
    { LDB(B0, 0, 0); LDA(At, 0, 0); STAGE_A(SA(1, 1), brow + HALF, nt - 1);
      BAR; WAIT_L(0); MMA(0, 0, At, B0); BAR;
      LDB(B1, 0, 1); BAR; WAIT_L(0); MMA(0, 1, At, B1); BAR;
      LDA(At, 0, 1); WAIT_V(4); BAR; WAIT_L(0); MMA(1, 0, At, B0); MMA(1, 1, At, B1); BAR; }
    { LDB(B0, 1, 0); LDA(At, 1, 0); WAIT_V(2); BAR; WAIT_L(0); MMA(0, 0, At, B0); BAR;
      LDB(B1, 1, 1); WAIT_V(0); BAR; WAIT_L(0); MMA(0, 1, At, B1); BAR;
      LDA(At, 1, 1); BAR; WAIT_L(0); MMA(1, 0, At, B0); MMA(1, 1, At, B1); BAR; }
    if (wr == 0) BAR;
    const int cbrow = brow, cbcol = bcol, cks = ks;
    L += gridDim.x; have = L < nitems;
    if (have) { COMPUTE_OFFS(); TILE_COORDS(L); FIRST4(); }
    COMPUTE_OFFS();
    epi(acc, cbrow, cbcol, wr, wc, fr, fq, cks);
    COMPUTE_OFFS();
  }
#undef SA
#undef SB
}

DEVI int perm32(int rho) { const int n = rho >> 4, i = rho & 15; return 8 * (i >> 2) + 4 * n + (i & 3); }
DEVI int permrow(int R) { return (R & ~31) + perm32(R & 31); }
DEVI uint4 pack8(const f32x4& a, const f32x4& b) { uint4 w; w.x = cvt_pk_bf16(a[0], a[1]); w.y = cvt_pk_bf16(a[2], a[3]); w.z = cvt_pk_bf16(b[0], b[1]); w.w = cvt_pk_bf16(b[2], b[3]); return w; }
struct EpiSwiglu {
  bf16_t* H;
  DEVI void operator()(const f32x4 (&acc)[2][2][4][2], int brow, int bcol, int wr, int wc, int fr, int fq, int ks) const {
    const int hc0 = (bcol >> 1) + wc * 32 + fq * 8;
#pragma unroll
    for (int ai = 0; ai < 2; ++ai)
#pragma unroll
      for (int m = 0; m < 4; ++m) {
        const size_t row = brow + ai * 128 + wr * 64 + m * 16 + fr;
        f32x4 o[2];
#pragma unroll
        for (int n = 0; n < 2; ++n) {
          const f32x4 u = acc[ai][0][m][n], v = acc[ai][1][m][n];
#pragma unroll
          for (int e = 0; e < 4; ++e) o[n][e] = u[e] * __builtin_amdgcn_rcpf(1.f + __expf(-u[e])) * v[e];
        }
        *(uint4*)(H + row * FF + hc0) = pack8(o[0], o[1]);
      }
  }
};
struct EpiBf16 {
  bf16_t* O; int ldc; bf16_t* slab;
  DEVI void operator()(const f32x4 (&acc)[2][2][4][2], int brow, int bcol, int wr, int wc, int fr, int fq, int ks) const {
#pragma unroll
    for (int ai = 0; ai < 2; ++ai)
#pragma unroll
      for (int m = 0; m < 4; ++m) {
        const size_t row = brow + ai * 128 + wr * 64 + m * 16 + fr;
#pragma unroll
        for (int bj = 0; bj < 2; ++bj) {
          const uint4 w = pack8(acc[ai][bj][m][0], acc[ai][bj][m][1]);
          const int col = bcol + bj * 128 + wc * 32 + fq * 8;
          if (ks < 0) *(uint4*)(O + row * ldc + col) = w;
          else *(uint4*)(slab + ((size_t)ks * TCX + (row - TL)) * 1024 + col) = w;
        }
      }
  }
};
struct EpiFeat {
  bf16_t* Fr; bf16_t* Fl; bf16_t* VF; int dup_v;
  DEVI void operator()(const f32x4 (&acc)[2][2][4][2], int brow, int bcol, int wr, int wc, int fr, int fq, int ks) const {
#pragma unroll
    for (int bj = 0; bj < 2; ++bj) {
      const int col = bcol + bj * 128 + wc * 32 + fq * 8;
      int act = 0;
      if (col >= 3072) { const int q = col - 3072; if (q < 256) act = ((q >> 6) & 1) ? 0 : 1; else if (q < 672) act = 2; else act = 0; }
#pragma unroll
      for (int ai = 0; ai < 2; ++ai)
#pragma unroll
        for (int m = 0; m < 4; ++m) {
          const size_t row = brow + ai * 128 + wr * 64 + m * 16 + fr;
          f32x4 u0 = acc[ai][bj][m][0], u1 = acc[ai][bj][m][1];
          if (act == 1) { for (int e = 0; e < 4; ++e) { u0[e] = tanhf_(u0[e]); u1[e] = tanhf_(u1[e]); } }
          else if (act == 2) { for (int e = 0; e < 4; ++e) { u0[e] = sigmoidf_(u0[e]); u1[e] = sigmoidf_(u1[e]); } }
          const uint4 w = pack8(u0, u1);
          if (col < 3072) {
            *(uint4*)(Fr + (size_t)(col >> 10) * T * 1024 + row * 1024 + (col & 1023)) = w;
            if (dup_v && col >= 2048) *(uint4*)(VF + row * 1024 + (col & 1023)) = w;
          } else {
            *(uint4*)(Fl + row * 768 + (col - 3072)) = w;
          }
        }
    }
  }
};
struct EpiReadout {
  bf16_t* O; const bf16_t* Z; int add;
  DEVI void operator()(const f32x4 (&acc)[2][2][4][2], int brow, int bcol, int wr, int wc, int fr, int fq, int ks) const {
#pragma unroll
    for (int ai = 0; ai < 2; ++ai)
#pragma unroll
      for (int m = 0; m < 4; ++m) {
        const size_t row = brow + ai * 128 + wr * 64 + m * 16 + fr;
#pragma unroll
        for (int bj = 0; bj < 2; ++bj) {
          const size_t idx = row * 1024 + bcol + bj * 128 + wc * 32 + fq * 8;
          const f32x4 u0 = acc[ai][bj][m][0], u1 = acc[ai][bj][m][1];
          const uint4 z = *(const uint4*)(Z + idx);
          f32x4 o0 = {u0[0] * bflo(z.x), u0[1] * bfhi(z.x), u0[2] * bflo(z.y), u0[3] * bfhi(z.y)};
          f32x4 o1 = {u1[0] * bflo(z.z), u1[1] * bfhi(z.z), u1[2] * bflo(z.w), u1[3] * bfhi(z.w)};
          if (add) { const uint4 p = *(const uint4*)(O + idx);
            o0 += (f32x4){bflo(p.x), bfhi(p.x), bflo(p.y), bfhi(p.y)}; o1 += (f32x4){bflo(p.z), bfhi(p.z), bflo(p.w), bfhi(p.w)}; }
          *(uint4*)(O + idx) = pack8(o0, o1);
        }
      }
  }
};

DEVI void mod_job(KParams& p, int job, float* sm, int wave_s) {
  const int tid = opaque_tid(wave_s);
  const int i = job / 72, col0 = (job % 72) * 128;
  float* sc = sm;
  float* red = sm + 9 * 1024;
  const float* c = p.in[1]; const float* cc = p.in[3];
  for (int e = tid; e < 9 * 1024; e += NT) { const int r = e >> 10, k = e & 1023; const float v = r < 8 ? c[r * 1024 + k] : cc[k]; sc[e] = v / (1.f + expf(-v)); }
  __syncthreads();
  const int cq = tid & 31, ks = tid >> 5;
  const float* w = p.in[4] + (size_t)i * 1024 * 9216 + col0 + cq * 4;
  f32x4 acc[9];
#pragma unroll
  for (int r = 0; r < 9; ++r) acc[r] = (f32x4){0.f, 0.f, 0.f, 0.f};
  for (int k = ks * 64; k < ks * 64 + 64; ++k) {
    const f32x4 w4 = *(const f32x4*)(w + (size_t)k * 9216);
#pragma unroll
    for (int r = 0; r < 9; ++r) acc[r] += sc[r * 1024 + k] * w4;
  }
#pragma unroll
  for (int r = 0; r < 9; ++r) *(f32x4*)(red + (ks * 9 + r) * 128 + cq * 4) = acc[r];
  __syncthreads();
  float* MOD = (float*)(p.ws + WS_MOD);
  for (int e = tid; e < 9 * 128; e += NT) {
    const int r = e >> 7, c_ = e & 127;
    float s = p.in[5][i * 9216 + col0 + c_];
    for (int k2 = 0; k2 < 16; ++k2) s += red[(k2 * 9 + r) * 128 + c_];
    MOD[(size_t)(i * 9 + r) * 9216 + col0 + c_] = s;
  }
  __syncthreads();
}

template <class F> DEVI void conv_seg(bf16_t* dst, int ld, int nrows, int ncols, F f, unsigned char* smem, int wave_s) {
  uint4* tile = (uint4*)smem;
  const int tid0 = opaque_tid(wave_s);
  const int tn = nrows >> 6, tk = ncols >> 6, ntiles = tn * tk;
  for (int t = blockIdx.x; t < ntiles; t += gridDim.x) {
    const int n0 = (t % tn) << 6, k0 = (t / tn) << 6;
    {
      const int nl = tid0 & 63, kl = tid0 >> 6;
      float v[8];
#pragma unroll
      for (int i = 0; i < 8; ++i) v[i] = f(n0 + nl, k0 + kl * 8 + i);
      uint4 o; o.x = cvt_pk_bf16(v[0], v[1]); o.y = cvt_pk_bf16(v[2], v[3]); o.z = cvt_pk_bf16(v[4], v[5]); o.w = cvt_pk_bf16(v[6], v[7]);
      tile[nl * 8 + (kl ^ (nl & 7))] = o;
    }
    __syncthreads();
    {
      const int row = tid0 >> 3, ch = tid0 & 7;
      *(uint4*)(dst + (size_t)(n0 + row) * ld + k0 + ch * 8) = tile[row * 8 + (ch ^ (row & 7))];
    }
    __syncthreads();
  }
}

DEVI void conv_layer(KParams& p, int i, unsigned char* smem, int wave_s) {
  bf16_t* wb = (bf16_t*)(p.ws + WS_WB);
  for (int h = 0; h < 2; ++h) {
    const float* w1 = p.in[7] + (size_t)(i * 2 + h) * D * FF;
    const float* w3 = p.in[8] + (size_t)(i * 2 + h) * D * FF;
    conv_seg(wb + WB_UP0 + (size_t)h * 5632 * 1024, 1024, 5632, 1024, [=](int R0, int k) -> float {
      const int R = permrow(R0); const int cidx = (R >> 8) * 128 + (R & 127); const float* s = ((R >> 7) & 1) ? w3 : w1; return s[(size_t)k * FF + cidx]; }, smem, wave_s);
    const float* w2 = p.in[9] + (size_t)(i * 2 + h) * FF * D;
    conv_seg(wb + WB_DN0 + (size_t)h * 1024 * 2816, 2816, 1024, 2816, [=](int n0, int k) -> float { const int n = permrow(n0); return w2[(size_t)k * D + n]; }, smem, wave_s);
  }
  const int kind = i % 3, j = i / 3;
  if (kind == 0) {
    const float* mu = p.in[10] + (size_t)j * 6 * 1024;
    const float* wr = p.in[11] + (size_t)j * D * D; const float* wk = p.in[12] + (size_t)j * D * D; const float* wv = p.in[13] + (size_t)j * D * D;
    const float* w1 = p.in[19] + (size_t)j * 2 * 1024 * 64; const float* a1 = p.in[22] + (size_t)j * 2 * 1024 * 64;
    const float* g1 = p.in[24] + (size_t)j * 2 * 1024 * 160; const float* v1 = j > 0 ? p.in[29] + (size_t)(j - 1) * 1024 * 32 : nullptr;
    conv_seg(wb + WB_MIX, 2048, 3840, 2048, [=](int R0, int k) -> float {
      const int R = permrow(R0); const int kk = k & 1023; const float* s; int ld, col, m;
      if (R < 3072) { const int which = R >> 10; s = which == 0 ? wr : (which == 1 ? wk : wv); ld = 1024; col = R & 1023; m = which == 0 ? 0 : (which == 1 ? 2 : 3); }
      else { const int q = R - 3072;
        if (q < 256) { const int dd = q >> 7, sub = (q >> 6) & 1; col = q & 63; ld = 64; s = (sub ? a1 : w1) + (size_t)dd * 1024 * 64; m = sub ? 4 : 1; }
        else if (q < 416) { s = g1; ld = 160; col = q - 256; m = 5; }
        else if (q < 512) return 0.f;
        else if (q < 672) { s = g1 + (size_t)1024 * 160; ld = 160; col = q - 512; m = 5; }
        else if (q < 704) { if (!v1) return 0.f; s = v1; ld = 32; col = q - 672; m = 3; }
        else return 0.f; }
      const float w = s[(size_t)kk * ld + col]; const float muv = mu[m * 1024 + kk];
      return k < 1024 ? w * (1.f - muv) : w * muv; }, smem, wave_s);
    const float* wo = p.in[14] + (size_t)j * D * D;
    conv_seg(wb + WB_WO, 1024, 1024, 1024, [=](int n0, int k) -> float { const int n = permrow(n0); return wo[(size_t)k * D + n]; }, smem, wave_s);
    const float* g2 = p.in[25] + (size_t)j * 2 * 160 * 1024;
    for (int d = 0; d < 2; ++d)
      conv_seg(wb + WB_G2T + (size_t)d * 1024 * 256, 256, 1024, 256, [=](int n0, int k) -> float { const int n = permrow(n0); return k < 160 ? g2[((size_t)d * 160 + k) * 1024 + n] : 0.f; }, smem, wave_s);
  } else {
    const int o = kind == 1 ? 31 : 37;
    const float* wq = p.in[o]; const float* wk = p.in[o + 1]; const float* wv = p.in[o + 2]; const float* wo = p.in[o + 3];
    conv_seg(wb + WB_MIX, 1024, 1536, 1024, [=](int R0, int k) -> float {
      const int R = permrow(R0); return R < 1024 ? wq[(size_t)k * 1024 + R] : (R < 1280 ? wk[(size_t)k * 256 + (R - 1024)] : wv[(size_t)k * 256 + (R - 1280)]); }, smem, wave_s);
    conv_seg(wb + WB_WO, 1024, 1024, 1024, [=](int n0, int k) -> float { const int n = permrow(n0); return wo[(size_t)k * D + n]; }, smem, wave_s);
  }
}

DEVI void rope_table(KParams& p, int wave_s) {
  float2* rt = (float2*)(p.ws + WS_ROPE);
  const int tid0 = opaque_tid(wave_s);
  for (int idx = blockIdx.x * NT + tid0; idx < 4096 * 32; idx += gridDim.x * NT) {
    const int pos = idx >> 5, axis = (idx >> 4) & 1, f = idx & 15;
    const float inv = powf(10000.f, -(float)f / 16.f);
    const float ang = (float)(axis ? (pos & 63) : (pos >> 6)) * inv;
    float s, c; sincosf(ang, &s, &c);
    rt[idx] = make_float2(c, s);
  }
}

struct RowPass {
  const float* xl; const float* xc; float* ol; float* oc;
  const bf16_t* y; const bf16_t* yslab; int nslab; const float* gpost; const float* modg; int mgate; float coef;
  bf16_t* n; const float* gpre; const float* modn; int mshift, mscale; int tmax;
};
DEVI void rowpass(const RowPass& a, int wave_s) {
  const int tid0 = opaque_tid(wave_s);
  const int wave = tid0 >> 6, lane = tid0 & 63;
  const int stride = gridDim.x * 8;
  int t = blockIdx.x * 8 + wave;
  if (t >= a.tmax) return;
  const bool upd = a.y != nullptr, nrm = a.n != nullptr;
  f32x4 gp[4], gpre[4], gt[4], sh[4], sc[4];
#pragma unroll
  for (int q = 0; q < 4; ++q) {
    const int c = q * 256 + lane * 4;
    gp[q] = upd ? *(const f32x4*)(a.gpost + c) : (f32x4){0.f, 0.f, 0.f, 0.f};
    gpre[q] = nrm ? *(const f32x4*)(a.gpre + c) : (f32x4){0.f, 0.f, 0.f, 0.f};
    gt[q] = gp[q]; sh[q] = gp[q]; sc[q] = gp[q];
  }
  int rcur = -1;
  f32x4 xA[4]; uint2 yA[4];
#define RP_LOAD(X_, Y_, t_) do { const bool lat_ = (t_) < TL; \
    const float* xs_ = lat_ ? a.xl + (size_t)(t_) * D : a.xc + (size_t)((t_) - TL) * D; \
    for (int q = 0; q < 4; ++q) X_[q] = __builtin_nontemporal_load((const f32x4*)(xs_ + q * 256 + lane * 4)); \
    if (upd && (lat_ || a.nslab == 0)) { for (int q = 0; q < 4; ++q) Y_[q] = *(const uint2*)(a.y + (size_t)(t_) * D + q * 256 + lane * 4); } } while (0)
  f32x4 xB[4]; uint2 yB[4];
  RP_LOAD(xA, yA, t);
#pragma unroll
  for (int q = 0; q < 4; ++q) { xB[q] = xA[q]; yB[q] = yA[q]; }
  if (t + stride < a.tmax) RP_LOAD(xB, yB, t + stride);
  while (true) {
    const int tn = t + stride;
    const bool more = tn < a.tmax;
    f32x4 xC[4]; uint2 yC[4];
#pragma unroll
    for (int q = 0; q < 4; ++q) { xC[q] = xB[q]; yC[q] = yB[q]; }
    if (tn + stride < a.tmax) RP_LOAD(xC, yC, tn + stride);
    const bool lat = t < TL; const int r = lat ? (t >> 12) : 8;
    if (r != rcur) {
      rcur = r;
#pragma unroll
      for (int q = 0; q < 4; ++q) {
        const int c = q * 256 + lane * 4;
        if (upd) gt[q] = *(const f32x4*)(a.modg + (size_t)r * 9216 + a.mgate * 1024 + c);
        if (nrm) { sh[q] = *(const f32x4*)(a.modn + (size_t)r * 9216 + a.mshift * 1024 + c); sc[q] = *(const f32x4*)(a.modn + (size_t)r * 9216 + a.mscale * 1024 + c); }
      }
    }
    float* xo = lat ? a.ol + (size_t)t * D : a.oc + (size_t)(t - TL) * D;
    f32x4 x[4];
#pragma unroll
    for (int q = 0; q < 4; ++q) x[q] = xA[q];
    if (upd) {
      f32x4 yv[4]; float ss = 0.f;
#pragma unroll
      for (int q = 0; q < 4; ++q) {
        if (lat || a.nslab == 0) {
          yv[q] = (f32x4){bflo(yA[q].x), bfhi(yA[q].x), bflo(yA[q].y), bfhi(yA[q].y)};
        } else {
          yv[q] = (f32x4){0.f, 0.f, 0.f, 0.f};
          for (int sl = 0; sl < a.nslab; ++sl) {
            const uint2 u = *(const uint2*)(a.yslab + ((size_t)sl * TCX + (t - TL)) * D + q * 256 + lane * 4);
            yv[q] += (f32x4){bflo(u.x), bfhi(u.x), bflo(u.y), bfhi(u.y)};
          }
        }
        ss += yv[q][0] * yv[q][0] + yv[q][1] * yv[q][1] + yv[q][2] * yv[q][2] + yv[q][3] * yv[q][3];
      }
      ss = wave_sum(ss);
      const float rs = __builtin_amdgcn_rsqf(ss * (1.f / D) + 1e-6f);
#pragma unroll
      for (int q = 0; q < 4; ++q) {
        x[q] += a.coef * gt[q] * (yv[q] * rs * gp[q]);
        __builtin_nontemporal_store(x[q], (f32x4*)(xo + q * 256 + lane * 4));
      }
    }
    if (nrm) {
      float ss = 0.f;
#pragma unroll
      for (int q = 0; q < 4; ++q) ss += x[q][0] * x[q][0] + x[q][1] * x[q][1] + x[q][2] * x[q][2] + x[q][3] * x[q][3];
      ss = wave_sum(ss);
      const float rs = __builtin_amdgcn_rsqf(ss * (1.f / D) + 1e-6f);
#pragma unroll
      for (int q = 0; q < 4; ++q) {
        const f32x4 v = x[q] * rs * gpre[q] * (1.f + sc[q]) + sh[q];
        uint2 w; w.x = cvt_pk_bf16(v[0], v[1]); w.y = cvt_pk_bf16(v[2], v[3]);
        *(uint2*)(a.n + (size_t)t * D + q * 256 + lane * 4) = w;
      }
    }
    if (!more) break;
#pragma unroll
    for (int q = 0; q < 4; ++q) { xA[q] = xB[q]; yA[q] = yB[q]; xB[q] = xC[q]; yB[q] = yC[q]; }
    t = tn;
  }
#undef RP_LOAD
}

DEVI void shift_phase(const bf16_t* n, bf16_t* s, int wave_s) {
  const int tid0 = opaque_tid(wave_s);
  for (int idx = blockIdx.x * NT + tid0; idx < T * 128; idx += gridDim.x * NT) {
    const int t = idx >> 7, c = (idx & 127) * 8;
    const bool lat = t < TL; const int pos = lat ? (t & 4095) : ((t - TL) & 255); const int last = lat ? 4095 : 255;
    uint4 a = {0, 0, 0, 0}, b = {0, 0, 0, 0};
    if (pos > 0) a = *(const uint4*)(n + (size_t)(t - 1) * D + c);
    if (pos < last) b = *(const uint4*)(n + (size_t)(t + 1) * D + c);
    uint4 o;
    o.x = cvt_pk_bf16(0.5f * (bflo(a.x) + bflo(b.x)), 0.5f * (bfhi(a.x) + bfhi(b.x)));
    o.y = cvt_pk_bf16(0.5f * (bflo(a.y) + bflo(b.y)), 0.5f * (bfhi(a.y) + bfhi(b.y)));
    o.z = cvt_pk_bf16(0.5f * (bflo(a.z) + bflo(b.z)), 0.5f * (bfhi(a.z) + bfhi(b.z)));
    o.w = cvt_pk_bf16(0.5f * (bflo(a.w) + bflo(b.w)), 0.5f * (bfhi(a.w) + bfhi(b.w)));
    *(uint4*)(s + (size_t)t * D + c) = o;
  }
}

DEVI void head16(float (&v)[16], int qq, bool do_norm, const float* gvec, bool do_rope, const float2* rt_pos, float scale) {
  if (do_norm) {
    float ss = 0.f;
#pragma unroll
    for (int e = 0; e < 16; ++e) ss += v[e] * v[e];
    ss += dppf<0xB1>(ss); ss += dppf<0x4E>(ss);
    const float rs = 1.f / sqrtf(ss * (1.f / 64.f) + 1e-6f);
#pragma unroll
    for (int e = 0; e < 16; ++e) v[e] = v[e] * rs * gvec[qq * 16 + e];
  }
  float pv[16];
#pragma unroll
  for (int e = 0; e < 16; ++e) pv[e] = dppf<0xB1>(v[e]);
  if (do_rope) {
    const int axis = qq >> 1, half = qq & 1;
#pragma unroll
    for (int e = 0; e < 16; ++e) {
      const float2 cs = rt_pos[axis * 16 + e];
      v[e] = half ? (v[e] * cs.x + pv[e] * cs.y) : (v[e] * cs.x - pv[e] * cs.y);
    }
  }
#pragma unroll
  for (int e = 0; e < 16; ++e) v[e] *= scale;
}
DEVI void load16(const bf16_t* src, float (&v)[16]) {
  const uint4 a = *(const uint4*)src, b = *(const uint4*)(src + 8);
  v[0] = bflo(a.x); v[1] = bfhi(a.x); v[2] = bflo(a.y); v[3] = bfhi(a.y); v[4] = bflo(a.z); v[5] = bfhi(a.z); v[6] = bflo(a.w); v[7] = bfhi(a.w);
  v[8] = bflo(b.x); v[9] = bfhi(b.x); v[10] = bflo(b.y); v[11] = bfhi(b.y); v[12] = bflo(b.z); v[13] = bfhi(b.z); v[14] = bflo(b.w); v[15] = bfhi(b.w);
}
DEVI void store16(bf16_t* dst, const float (&v)[16]) {
  uint4 a, b;
  a.x = cvt_pk_bf16(v[0], v[1]); a.y = cvt_pk_bf16(v[2], v[3]); a.z = cvt_pk_bf16(v[4], v[5]); a.w = cvt_pk_bf16(v[6], v[7]);
  b.x = cvt_pk_bf16(v[8], v[9]); b.y = cvt_pk_bf16(v[10], v[11]); b.z = cvt_pk_bf16(v[12], v[13]); b.w = cvt_pk_bf16(v[14], v[15]);
  *(uint4*)dst = a; *(uint4*)(dst + 8) = b;
}
DEVI void attn_post(KParams& p, int mode, unsigned char* smem, int wave_s) {
  bf16_t* R = (bf16_t*)(p.ws + WS_R);
  const bf16_t* QKV = R; bf16_t* Qb = R + R_QB; bf16_t* Kb = R + R_KB; bf16_t* Vt = R + R_VT;
  const float2* rt = (const float2*)(p.ws + WS_ROPE);
  const float* gq = p.in[35]; const float* gk = p.in[36];
  bf16_t* Vs = (bf16_t*)smem;
  const int tid = opaque_tid(wave_s), wave = tid >> 6, lane = tid & 63;
  const float qscale = 0.125f * 1.4426950408889634f;
  for (int job = blockIdx.x; job < T / 64; job += gridDim.x) {
    const int t0 = job * 64; const bool lat = t0 < TL;
    const int b = lat ? (t0 >> 12) : ((t0 - TL) >> 8);
    const int key0 = lat ? (t0 & 4095) : (4096 + ((t0 - TL) & 255));
    for (int it = 0; it < 8; ++it) {
      const int tt = it * 8 + wave; const int t = t0 + tt;
      const int pos = lat ? (t & 4095) : 0;
      const bf16_t* raw = QKV + (size_t)t * 1536;
      const float2* rtp = rt + pos * 32;
      float v[16];
      load16(raw + lane * 16, v);
      head16(v, lane & 3, mode == 0, gq, lat, rtp, qscale);
      store16(Qb + (size_t)t * 1024 + lane * 16, v);
      const int kl = lane & 15;
      load16(raw + 1024 + kl * 16, v);
      head16(v, lane & 3, mode == 0, gk, lat, rtp, 1.f);
      if (lane < 16) store16(Kb + ((size_t)(b * 4 + (kl >> 2)) * LK + key0 + tt) * 64 + (kl & 3) * 16, v);
      if (lane < 32) {
        const uint4 u = *(const uint4*)(raw + 1280 + lane * 8);
        const int r0 = lane * 8;
        Vs[(r0 + 0) * 72 + tt] = (bf16_t)(u.x & 0xffff); Vs[(r0 + 1) * 72 + tt] = (bf16_t)(u.x >> 16);
        Vs[(r0 + 2) * 72 + tt] = (bf16_t)(u.y & 0xffff); Vs[(r0 + 3) * 72 + tt] = (bf16_t)(u.y >> 16);
        Vs[(r0 + 4) * 72 + tt] = (bf16_t)(u.z & 0xffff); Vs[(r0 + 5) * 72 + tt] = (bf16_t)(u.z >> 16);
        Vs[(r0 + 6) * 72 + tt] = (bf16_t)(u.w & 0xffff); Vs[(r0 + 7) * 72 + tt] = (bf16_t)(u.w >> 16);
      }
    }
    __syncthreads();
    {
      const int row = tid >> 1, hf = tid & 1;
      bf16_t* dst = Vt + ((size_t)b * 256 + row) * LK + key0 + hf * 32;
      const bf16_t* src = Vs + row * 72 + hf * 32;
#pragma unroll
      for (int i = 0; i < 4; ++i) *(uint4*)(dst + i * 8) = *(const uint4*)(src + i * 8);
    }
    __syncthreads();
  }
}

DEVI void attn_core(KParams& p, int mode, unsigned char* smem, int wave_s) {
  bf16_t* R = (bf16_t*)(p.ws + WS_R);
  const bf16_t* Qb = R + R_QB; const bf16_t* Kb = R + R_KB; const bf16_t* Vt = R + R_VT; bf16_t* O = R;
  const float* sink = p.in[41];
  bf16_t* KV = (bf16_t*)smem;
  const int tid = opaque_tid(wave_s), wave = tid >> 6, lane = tid & 63, l31 = lane & 31, hi = lane >> 5;
  const int nlat = 8 * 16 * 8, nitems = nlat + 8 * 16;
  for (int item = blockIdx.x; item < nitems; item += gridDim.x) {
    int b, h, q0; bool lat;
    if (item < nlat && gridDim.x == 256) {
      lat = true; const int rnd = item >> 8, bid_ = item & 255, xcd = bid_ & 7, slot = bid_ >> 3;
      const int grp = rnd * 8 + xcd;
      b = grp >> 2; const int kvh = grp & 3, g = slot >> 3, qb = slot & 7; h = kvh * 4 + g; q0 = qb * 512; }
    else if (item < nlat) { lat = true; b = item >> 7; const int kvh = (item >> 5) & 3, g = (item >> 3) & 3, qb = item & 7; h = kvh * 4 + g; q0 = qb * 512; }
    else { lat = false; const int r = item - nlat; b = r >> 4; h = r & 15; q0 = 0; }
    const int kvh = h >> 2;
    int qrow[2]; size_t tq[2];
    bf16x8 bq[2][4];
#pragma unroll
    for (int rg = 0; rg < 2; ++rg) {
      const int rloc = wave * 64 + rg * 32 + l31;
      qrow[rg] = lat ? q0 + rloc : (rloc & 255);
      tq[rg] = lat ? ((size_t)b * 4096 + qrow[rg]) : ((size_t)TL + b * 256 + qrow[rg]);
#pragma unroll
      for (int ks = 0; ks < 4; ++ks) bq[rg][ks] = *(const bf16x8*)(Qb + tq[rg] * 1024 + h * 64 + ks * 16 + hi * 8);
    }
    int a0 = 0, a1 = 0;
    if (lat) { if (mode == 0) { a0 = 0; a1 = 64; } else { a0 = max(0, q0 - 128) >> 6; a1 = min(4096, q0 + 512 + 128) >> 6; } }
    const int n1 = a1 - a0, ntile = n1 + 4;
    float m_run[2], l_run[2];
    f32x16 ot[2][2];
#pragma unroll
    for (int rg = 0; rg < 2; ++rg) {
      if (mode == 1) { m_run[rg] = sink[h] * 1.4426950408889634f; l_run[rg] = hi == 0 ? 1.f : 0.f; } else { m_run[rg] = -1e30f; l_run[rg] = 0.f; }
#pragma unroll
      for (int e = 0; e < 16; ++e) { ot[rg][0][e] = 0.f; ot[rg][1][e] = 0.f; }
    }
    const bf16_t* Kbase = Kb + (size_t)(b * 4 + kvh) * LK * 64;
    const bf16_t* Vbase = Vt + (size_t)(b * 4 + kvh) * 64 * LK;
    const int ldrow = tid >> 3, ldseg = tid & 7;
    uint4 kreg, vreg;
#define KT_OF(it_) ((it_) < n1 ? a0 + (it_) : 64 + ((it_) - n1))
#define KV_LOAD(it_) do { const int kt_ = KT_OF(it_); \
      kreg = *(const uint4*)(Kbase + ((size_t)kt_ * 64 + ldrow) * 64 + ldseg * 8); \
      vreg = *(const uint4*)(Vbase + (size_t)ldrow * LK + kt_ * 64 + ldseg * 8); } while (0)
#define KV_STORE(buf_) do { *(uint4*)(KV + (buf_) * 9216 + ldrow * 72 + ldseg * 8) = kreg; *(uint4*)(KV + (buf_) * 9216 + 4608 + ldrow * 72 + ldseg * 8) = vreg; } while (0)
    __syncthreads();
    KV_LOAD(0); KV_STORE(0);
    if (ntile > 1) KV_LOAD(1);
    __syncthreads();
    for (int it = 0; it < ntile; ++it) {
      const int kt = KT_OF(it);
      const bf16_t* Ks = KV + (it & 1) * 9216;
      const bf16_t* Vts = Ks + 4608;
      if (it + 1 < ntile) KV_STORE((it + 1) & 1);
      if (it + 2 < ntile) KV_LOAD(it + 2);
      const int wq0 = q0 + wave * 64;
      const bool act = !(mode == 1 && lat && kt < 64) || (kt * 64 + 63 >= wq0 - 128 && kt * 64 <= wq0 + 63 + 128);
      if (act) {
      f32x16 st[2][2];
#pragma unroll
      for (int kb = 0; kb < 2; ++kb) {
#pragma unroll
        for (int e = 0; e < 16; ++e) { st[0][kb][e] = 0.f; st[1][kb][e] = 0.f; }
#pragma unroll
        for (int ks = 0; ks < 4; ++ks) {
          const bf16x8 ak = *(const bf16x8*)(Ks + (kb * 32 + l31) * 72 + ks * 16 + hi * 8);
          st[0][kb] = __builtin_amdgcn_mfma_f32_32x32x16_bf16(ak, bq[0][ks], st[0][kb], 0, 0, 0);
          st[1][kb] = __builtin_amdgcn_mfma_f32_32x32x16_bf16(ak, bq[1][ks], st[1][kb], 0, 0, 0);
        }
      }
      unsigned pk[2][2][2][4];
#pragma unroll
      for (int rg = 0; rg < 2; ++rg) {
        if (mode == 1 && kt < 64) {
#pragma unroll
          for (int kb = 0; kb < 2; ++kb)
#pragma unroll
            for (int e = 0; e < 16; ++e) {
              const int key = kt * 64 + kb * 32 + 8 * (e >> 2) + 4 * hi + (e & 3);
              const int rel = key - qrow[rg];
              if (rel > 128 || rel < -128) st[rg][kb][e] = -1e30f;
            }
        }
        float lmax = st[rg][0][0];
#pragma unroll
        for (int kb = 0; kb < 2; ++kb)
#pragma unroll
          for (int e = 0; e < 16; ++e) lmax = fmaxf(lmax, st[rg][kb][e]);
        if (__builtin_amdgcn_ballot_w64(lmax > m_run[rg] + 8.f) != 0) {
          float mx = fmaxf(m_run[rg], lmax);
          mx = fmaxf(mx, xor32f(mx, lane));
          const float alpha = __builtin_amdgcn_exp2f(m_run[rg] - mx);
          m_run[rg] = mx; l_run[rg] *= alpha;
#pragma unroll
          for (int e = 0; e < 16; ++e) { ot[rg][0][e] *= alpha; ot[rg][1][e] *= alpha; }
        }
        const float mx = m_run[rg];
#pragma unroll
        for (int kb = 0; kb < 2; ++kb)
#pragma unroll
          for (int e = 0; e < 16; ++e) { const float pe = __builtin_amdgcn_exp2f(st[rg][kb][e] - mx); st[rg][kb][e] = pe; l_run[rg] += pe; }
#pragma unroll
        for (int kb = 0; kb < 2; ++kb)
#pragma unroll
          for (int ip = 0; ip < 2; ++ip) {
            pk[rg][kb][ip][0] = cvt_pk_bf16(st[rg][kb][8 * ip + 0], st[rg][kb][8 * ip + 1]); pk[rg][kb][ip][1] = cvt_pk_bf16(st[rg][kb][8 * ip + 2], st[rg][kb][8 * ip + 3]);
            pk[rg][kb][ip][2] = cvt_pk_bf16(st[rg][kb][8 * ip + 4], st[rg][kb][8 * ip + 5]); pk[rg][kb][ip][3] = cvt_pk_bf16(st[rg][kb][8 * ip + 6], st[rg][kb][8 * ip + 7]);
          }
      }
#pragma unroll
      for (int kb = 0; kb < 2; ++kb)
#pragma unroll
        for (int ip = 0; ip < 2; ++ip) {
          union { unsigned u[4]; bf16x8 v; } pb0, pb1;
#pragma unroll
          for (int q = 0; q < 4; ++q) { pb0.u[q] = pk[0][kb][ip][q]; pb1.u[q] = pk[1][kb][ip][q]; }
          const int keyoff = kb * 32 + ip * 16 + 4 * hi;
#pragma unroll
          for (int db = 0; db < 2; ++db) {
            union { uint2 u[2]; bf16x8 v; } av;
            av.u[0] = *(const uint2*)(Vts + (db * 32 + l31) * 72 + keyoff);
            av.u[1] = *(const uint2*)(Vts + (db * 32 + l31) * 72 + keyoff + 8);
            ot[0][db] = __builtin_amdgcn_mfma_f32_32x32x16_bf16(av.v, pb0.v, ot[0][db], 0, 0, 0);
            ot[1][db] = __builtin_amdgcn_mfma_f32_32x32x16_bf16(av.v, pb1.v, ot[1][db], 0, 0, 0);
          }
        }
      }
      __syncthreads();
    }
#pragma unroll
    for (int rg = 0; rg < 2; ++rg) {
      const float ltot = l_run[rg] + xor32f(l_run[rg], lane);
      const float inv = 1.f / ltot;
#pragma unroll
      for (int db = 0; db < 2; ++db)
#pragma unroll
        for (int i = 0; i < 4; ++i) {
          uint2 w; w.x = cvt_pk_bf16(ot[rg][db][4 * i] * inv, ot[rg][db][4 * i + 1] * inv); w.y = cvt_pk_bf16(ot[rg][db][4 * i + 2] * inv, ot[rg][db][4 * i + 3] * inv);
          *(uint2*)(O + tq[rg] * 1024 + h * 64 + db * 32 + 8 * i + 4 * hi) = w;
        }
    }
  }
}

typedef float f32x2 __attribute__((ext_vector_type(2)));
struct StepOps { f32x4 a0, a1, w0, w1, k0, k1, b0, b1, r0, r1; f32x2 v; f32x2 sc; };
constexpr int OPS_STRIDE = 6 * 2048 + 64;
DEVI void scan_load(StepOps& o, const float* base, int off, int kq, int r2) {
  const float* q = base + off + kq * 8;
  o.w0 = *(const f32x4*)(q); o.w1 = *(const f32x4*)(q + 4);
  o.k0 = *(const f32x4*)(q + 2048); o.k1 = *(const f32x4*)(q + 2048 + 4);
  o.a0 = *(const f32x4*)(q + 4096); o.a1 = *(const f32x4*)(q + 4096 + 4);
  o.b0 = *(const f32x4*)(q + 6144); o.b1 = *(const f32x4*)(q + 6144 + 4);
  o.r0 = *(const f32x4*)(q + 8192); o.r1 = *(const f32x4*)(q + 8192 + 4);
  o.v = *(const f32x2*)(base + 10240 + off + 2 * r2);
  o.sc = *(const f32x2*)(base + 12288 + (off >> 5));
}
#define LO2(x) ((f32x2){(x)[0], (x)[1]})
#define HI2(x) ((f32x2){(x)[2], (x)[3]})
DEVI float scan_step(f32x2 (&S)[4], const StepOps& o, float vrow) {
  f32x2 p0 = S[0] * LO2(o.a0), p1 = S[1] * HI2(o.a0);
  f32x2 q0 = S[0] * LO2(o.r0), q1 = S[1] * HI2(o.r0);
  p0 = S[2] * LO2(o.a1) + p0; p1 = S[3] * HI2(o.a1) + p1;
  q0 = S[2] * LO2(o.r1) + q0; q1 = S[3] * HI2(o.r1) + q1;
  p0 += p1; q0 += q1;
  float sa = p0.x + p0.y, yy = q0.x + q0.y;
  sa += dppf<0xB1>(sa); yy += dppf<0xB1>(yy);
  sa += dppf<0x4E>(sa); yy += dppf<0x4E>(yy);
  sa += dppf<0x141>(sa); yy += dppf<0x141>(yy);
  const f32x2 sa2 = {sa, sa}, v2 = {vrow, vrow};
  S[0] = S[0] * LO2(o.w0) + (sa2 * LO2(o.b0) + v2 * LO2(o.k0));
  S[1] = S[1] * HI2(o.w0) + (sa2 * HI2(o.b0) + v2 * HI2(o.k0));
  S[2] = S[2] * LO2(o.w1) + (sa2 * LO2(o.b1) + v2 * LO2(o.k1));
  S[3] = S[3] * HI2(o.w1) + (sa2 * HI2(o.b1) + v2 * HI2(o.k1));
  return yy + sa * o.sc.x + vrow * o.sc.y;
}
DEVI void unpack8(const uint4& u, float (&v)[8]) {
  v[0] = bflo(u.x); v[1] = bfhi(u.x); v[2] = bflo(u.y); v[3] = bfhi(u.y); v[4] = bflo(u.z); v[5] = bfhi(u.z); v[6] = bflo(u.w); v[7] = bfhi(u.w);
}
DEVI void scan_phase(KParams& p, int j, unsigned char* smem, int wave_s) {
  bf16_t* R = (bf16_t*)(p.ws + WS_R);
  const bf16_t* Fr = R; const bf16_t* Fk = R + (size_t)T * 1024; const bf16_t* Fv = R + (size_t)2 * T * 1024; const bf16_t* Fl = R + R_FL;
  const bf16_t* VF = (const bf16_t*)(p.ws + WS_VF);
  float* sm = (float*)smem;
  float* cst = sm;
  float* OPS = cst + 512;
  float* YB = OPS + 2 * OPS_STRIDE;
  float* RKB = YB + 4096;
  float* XS = RKB + 64;
  uint4* BL = (uint4*)(XS + 6144);
  const int tid = opaque_tid(wave_s);
  const int wave = tid >> 6, lane = tid & 63;
  for (int item = blockIdx.x; item < 256; item += gridDim.x) {
    const int b = item & 7, d = (item >> 3) & 1, h = item >> 4;
    bf16_t* Z = (bf16_t*)(p.ws + (d ? WS_N2 : WS_N1));
#define CHUNK_BASE(ci_) ((ci_) < 8 ? (TL + b * 256 + (d ? (7 - (ci_)) : (ci_)) * 32) : (b * 4096 + (d ? (127 - ((ci_) - 8)) : ((ci_) - 8)) * 32))
    __syncthreads();
    if (tid < 64) {
      const int c = h * 64 + tid;
      cst[tid] = p.in[18][(j * 2 + d) * 1024 + c]; cst[64 + tid] = p.in[21][(j * 2 + d) * 1024 + c];
      cst[128 + tid] = p.in[15][j * 1024 + c]; cst[192 + tid] = p.in[16][j * 1024 + c]; cst[256 + tid] = p.in[17][j * 1024 + c];
      cst[320 + tid] = p.in[26][(j * 2 + d) * 1024 + c]; cst[384 + tid] = p.in[27][(j * 2 + d) * 1024 + c];
      cst[448 + tid] = j > 0 ? p.in[28][(j - 1) * 1024 + c] : 0.f;
    }
    {
      const int fr = lane & 15, fq = lane >> 4, ct = wave >> 1, ks = wave & 1;
      const float* a2s = p.in[23] + ((size_t)(j * 2 + d) * 64) * 1024 + h * 64 + fr;
      uint4 o;
      { const size_t ro = (size_t)(ks * 32 + fq * 8) * 1024 + ct * 16;
        o.x = cvt_pk_bf16(a2s[ro], a2s[ro + 1024]); o.y = cvt_pk_bf16(a2s[ro + 2048], a2s[ro + 3072]);
        o.z = cvt_pk_bf16(a2s[ro + 4096], a2s[ro + 5120]); o.w = cvt_pk_bf16(a2s[ro + 6144], a2s[ro + 7168]); }
      BL[wave * 64 + lane] = o;
      if (wave < 4) {
        uint4 z = {0, 0, 0, 0};
        if (j > 0) {
          const float* v2s = p.in[30] + (size_t)(j - 1) * 32 * 1024 + h * 64 + fr;
          const size_t ro = (size_t)(fq * 8) * 1024 + wave * 16;
          z.x = cvt_pk_bf16(v2s[ro], v2s[ro + 1024]); z.y = cvt_pk_bf16(v2s[ro + 2048], v2s[ro + 3072]);
          z.z = cvt_pk_bf16(v2s[ro + 4096], v2s[ro + 5120]); z.w = cvt_pk_bf16(v2s[ro + 6144], v2s[ro + 7168]);
        }
        BL[(8 + wave) * 64 + lane] = z;
      }
    }
    __syncthreads();
    if (wave >= 4) {
      const int pw = wave - 4, fr = lane & 15, fq = lane >> 4, tkl = lane >> 3, c8 = (lane & 7) * 8;
      float* X = XS + pw * 1536;
      union BF { unsigned u[4]; bf16x8 v; };
      BF bw2[4][2];
      {
        const float* w2s = p.in[20] + ((size_t)(j * 2 + d) * 64) * 1024 + h * 64 + fr;
#pragma unroll
        for (int ct = 0; ct < 4; ++ct)
#pragma unroll
          for (int ks = 0; ks < 2; ++ks)
#pragma unroll
            for (int q = 0; q < 4; ++q) {
              const size_t ro = (size_t)(ks * 32 + fq * 8 + 2 * q) * 1024 + ct * 16;
              bw2[ct][ks].u[q] = cvt_pk_bf16(w2s[ro], w2s[ro + 1024]);
            }
      }
      struct PrepRegs { uint4 ur, uk, uv, uvf; bf16x8 alw[2], ala[2], alv; };
#define PREP_LOAD(N_, nc_) do { const int gb_ = CHUNK_BASE(nc_); const size_t tokA_ = (size_t)gb_ + pw * 8 + (fr & 7), gt_ = (size_t)gb_ + pw * 8 + tkl; \
        N_.ur = *(const uint4*)(Fr + gt_ * 1024 + h * 64 + c8); N_.uk = *(const uint4*)(Fk + gt_ * 1024 + h * 64 + c8); N_.uv = *(const uint4*)(Fv + gt_ * 1024 + h * 64 + c8); \
        N_.uvf = (uint4){0, 0, 0, 0}; if (j > 0) N_.uvf = *(const uint4*)(VF + gt_ * 1024 + h * 64 + c8); \
        for (int ks = 0; ks < 2; ++ks) { N_.alw[ks] = *(const bf16x8*)(Fl + tokA_ * 768 + d * 128 + ks * 32 + fq * 8); N_.ala[ks] = *(const bf16x8*)(Fl + tokA_ * 768 + d * 128 + 64 + ks * 32 + fq * 8); } \
        N_.alv = N_.alw[0]; if (j > 0) N_.alv = *(const bf16x8*)(Fl + tokA_ * 768 + 672 + fq * 8); } while (0)
      PrepRegs NX;
      PREP_LOAD(NX, 0);
#pragma unroll 1
      for (int c = -1; c < 136; ++c) {
        if (c >= 1) {
          const int pc = c - 1, buf = pc & 1, tr = pw * 8 + tkl;
          const float* O = OPS + buf * OPS_STRIDE;
          const size_t gt = (size_t)CHUNK_BASE(pc) + tr;
          const f32x4 ya = *(const f32x4*)(YB + buf * 2048 + tr * 64 + c8), yb = *(const f32x4*)(YB + buf * 2048 + tr * 64 + c8 + 4);
          const float mu = red8((ya[0] + ya[1] + ya[2] + ya[3]) + (yb[0] + yb[1] + yb[2] + yb[3])) * (1.f / 64.f);
          const f32x4 da = ya - mu, db = yb - mu;
          const float var = red8((da[0] * da[0] + da[1] * da[1] + da[2] * da[2] + da[3] * da[3]) + (db[0] * db[0] + db[1] * db[1] + db[2] * db[2] + db[3] * db[3])) * (1.f / 64.f);
          const float rs = __builtin_amdgcn_rsqf(var + 64e-5f);
          const float rk = RKB[buf * 32 + tr];
          const f32x4 va = *(const f32x4*)(O + 10240 + tr * 64 + c8), vb = *(const f32x4*)(O + 10240 + tr * 64 + c8 + 4);
          f32x4 oa, ob;
#pragma unroll
          for (int e = 0; e < 4; ++e) {
            oa[e] = da[e] * rs * cst[320 + c8 + e] + cst[384 + c8 + e] + rk * va[e];
            ob[e] = db[e] * rs * cst[320 + c8 + 4 + e] + cst[384 + c8 + 4 + e] + rk * vb[e];
          }
          *(uint4*)(Z + gt * 1024 + h * 64 + c8) = pack8(oa, ob);
        }
        if (c + 1 < 136) {
          const int nc = c + 1, buf = nc & 1, tr = pw * 8 + tkl;
          float* O = OPS + buf * OPS_STRIDE;
          const PrepRegs PC = NX;
          if (nc + 1 < 136) PREP_LOAD(NX, nc + 1);
          const uint4 ur = PC.ur, uk = PC.uk, uv = PC.uv, uvf = PC.uvf;
          bf16x8 alw[2], ala[2], alv;
          alw[0] = PC.alw[0]; alw[1] = PC.alw[1]; ala[0] = PC.ala[0]; ala[1] = PC.ala[1]; alv = PC.alv;
#pragma unroll
          for (int ct = 0; ct < 4; ++ct) {
            f32x4 cD = {0.f, 0.f, 0.f, 0.f}, cA = {0.f, 0.f, 0.f, 0.f}, cV = {0.f, 0.f, 0.f, 0.f};
            cD = __builtin_amdgcn_mfma_f32_16x16x32_bf16(alw[0], bw2[ct][0].v, cD, 0, 0, 0);
            cD = __builtin_amdgcn_mfma_f32_16x16x32_bf16(alw[1], bw2[ct][1].v, cD, 0, 0, 0);
            { BF t0, t1; *(uint4*)t0.u = BL[(ct * 2 + 0) * 64 + lane]; *(uint4*)t1.u = BL[(ct * 2 + 1) * 64 + lane];
              cA = __builtin_amdgcn_mfma_f32_16x16x32_bf16(ala[0], t0.v, cA, 0, 0, 0);
              cA = __builtin_amdgcn_mfma_f32_16x16x32_bf16(ala[1], t1.v, cA, 0, 0, 0); }
            if (j > 0) { BF t2; *(uint4*)t2.u = BL[(8 + ct) * 64 + lane]; cV = __builtin_amdgcn_mfma_f32_16x16x32_bf16(alv, t2.v, cV, 0, 0, 0); }
            if (fq < 2) {
#pragma unroll
              for (int q = 0; q < 4; ++q) {
                X[(fq * 4 + q) * 64 + ct * 16 + fr] = cD[q];
                X[512 + (fq * 4 + q) * 64 + ct * 16 + fr] = cA[q];
                X[1024 + (fq * 4 + q) * 64 + ct * 16 + fr] = cV[q];
              }
            }
          }
          asm volatile("s_waitcnt lgkmcnt(0)" ::: "memory");
          float ssq = 0.f, rks = 0.f, brs = 0.f, krs = 0.f;
          {
            float kr[8]; unpack8(uk, kr);
#pragma unroll
            for (int e = 0; e < 8; ++e) { const float t = kr[e] * cst[128 + c8 + e]; ssq += t * t; }
          }
          ssq = red8(ssq);
          const float kinv = __builtin_amdgcn_rcpf(fmaxf(sqrtf(ssq), 1e-12f));
          float* q = O + tr * 64 + c8;
#pragma unroll
          for (int hh = 0; hh < 2; ++hh) {
            const int co = c8 + hh * 4;
            const f32x4 dl = *(const f32x4*)(X + tkl * 64 + co), ap = *(const f32x4*)(X + 512 + tkl * 64 + co), vr = *(const f32x4*)(X + 1024 + tkl * 64 + co);
            const unsigned r0 = hh ? ur.z : ur.x, r1 = hh ? ur.w : ur.y, k0 = hh ? uk.z : uk.x, k1 = hh ? uk.w : uk.y;
            const unsigned v0 = hh ? uv.z : uv.x, v1 = hh ? uv.w : uv.y, f0 = hh ? uvf.z : uvf.x, f1 = hh ? uvf.w : uvf.y;
            const f32x4 rr = {bflo(r0), bfhi(r0), bflo(r1), bfhi(r1)}, kr = {bflo(k0), bfhi(k0), bflo(k1), bfhi(k1)};
            f32x4 vv = {bflo(v0), bfhi(v0), bflo(v1), bfhi(v1)};
            const f32x4 vf = {bflo(f0), bfhi(f0), bflo(f1), bfhi(f1)};
            f32x4 wd, kd, aa, bb, wr4;
#pragma unroll
            for (int e = 0; e < 4; ++e) {
              const float z = -(cst[co + e] + dl[e]);
              const float sp = fmaxf(z, 0.f) + __logf(1.f + __expf(-fabsf(z)));
              const float w = -sp - 0.5f;
              wd[e] = __expf(-__expf(w));
              const float a = __builtin_amdgcn_rcpf(1.f + __expf(-(cst[64 + co + e] + ap[e])));
              const float kk = kr[e] * cst[128 + co + e] * kinv;
              kd[e] = kr[e] * (1.f + (a - 1.f) * cst[192 + co + e]);
              aa[e] = -kk; bb[e] = kk * a;
              if (j > 0) vv[e] = vv[e] + (vf[e] - vv[e]) * __builtin_amdgcn_rcpf(1.f + __expf(-(cst[448 + co + e] + vr[e])));
              rks += rr[e] * kd[e] * cst[256 + co + e];
              wr4[e] = wd[e] * rr[e]; brs += bb[e] * rr[e]; krs += kd[e] * rr[e];
            }
            *(f32x4*)(q + hh * 4) = wd; *(f32x4*)(q + 2048 + hh * 4) = kd; *(f32x4*)(q + 4096 + hh * 4) = aa;
            *(f32x4*)(q + 6144 + hh * 4) = bb; *(f32x4*)(q + 8192 + hh * 4) = wr4; *(f32x4*)(q + 10240 + hh * 4) = vv;
          }
          rks = red8(rks); brs = red8(brs); krs = red8(krs);
          if ((lane & 7) == 0) { RKB[buf * 32 + tr] = rks; *(f32x2*)(O + 12288 + tr * 2) = (f32x2){brs, krs}; }
        }
        __syncthreads();
      }
      {
        const int pc = 135, buf = pc & 1, tr = pw * 8 + tkl;
        const float* O = OPS + buf * OPS_STRIDE;
        const size_t gt = (size_t)CHUNK_BASE(pc) + tr;
        const f32x4 ya = *(const f32x4*)(YB + buf * 2048 + tr * 64 + c8), yb = *(const f32x4*)(YB + buf * 2048 + tr * 64 + c8 + 4);
        const float mu = red8((ya[0] + ya[1] + ya[2] + ya[3]) + (yb[0] + yb[1] + yb[2] + yb[3])) * (1.f / 64.f);
        const f32x4 da = ya - mu, db = yb - mu;
        const float var = red8((da[0] * da[0] + da[1] * da[1] + da[2] * da[2] + da[3] * da[3]) + (db[0] * db[0] + db[1] * db[1] + db[2] * db[2] + db[3] * db[3])) * (1.f / 64.f);
        const float rs = __builtin_amdgcn_rsqf(var + 64e-5f);
        const float rk = RKB[buf * 32 + tr];
        const f32x4 va = *(const f32x4*)(O + 10240 + tr * 64 + c8), vb = *(const f32x4*)(O + 10240 + tr * 64 + c8 + 4);
        f32x4 oa, ob;
#pragma unroll
        for (int e = 0; e < 4; ++e) {
          oa[e] = da[e] * rs * cst[320 + c8 + e] + cst[384 + c8 + e] + rk * va[e];
          ob[e] = db[e] * rs * cst[320 + c8 + 4 + e] + cst[384 + c8 + 4 + e] + rk * vb[e];
        }
        *(uint4*)(Z + gt * 1024 + h * 64 + c8) = pack8(oa, ob);
      }
    } else {
      const int r2 = tid >> 3, kq = tid & 7;
      f32x2 S0[4], S1[4];
#pragma unroll
      for (int i = 0; i < 4; ++i) { S0[i] = (f32x2){0.f, 0.f}; S1[i] = (f32x2){0.f, 0.f}; }
      __syncthreads();
      __builtin_amdgcn_s_setprio(3);
#pragma unroll 1
      for (int c = 0; c < 136; ++c) {
        const float* base = OPS + (c & 1) * OPS_STRIDE;
        float* Y = YB + (c & 1) * 2048;
        const int o0 = d ? 31 * 64 : 0, dstep = d ? -64 : 64;
        StepOps A, B;
        scan_load(A, base, o0, kq, r2);
#define SCAN_PAIR(s_) do { const int oa = o0 + (s_) * dstep, ob = oa + dstep; \
          scan_load(B, base, ob, kq, r2); \
          { const float y0 = scan_step(S0, A, A.v.x), y1 = scan_step(S1, A, A.v.y); \
            if (kq == 0) *(f32x2*)(Y + oa + 2 * r2) = (f32x2){y0, y1}; } \
          scan_load(A, base, ob + dstep, kq, r2);        \
          { const float y0 = scan_step(S0, B, B.v.x), y1 = scan_step(S1, B, B.v.y); \
            if (kq == 0) *(f32x2*)(Y + ob + 2 * r2) = (f32x2){y0, y1}; } } while (0)
#pragma unroll 1
        for (int s = 0; s < 32; s += 4) { SCAN_PAIR(s); SCAN_PAIR(s + 2); }
        __syncthreads();
      }
      __builtin_amdgcn_s_setprio(0);
    }
  }
}

DEVI bool run_phase(KParams& p, int ph, unsigned char* smem, int wave_s) {
  unsigned char* ws = p.ws;
  float* MOD = (float*)(ws + WS_MOD);
  float* XC = (float*)(ws + WS_XC);
  bf16_t* WB = (bf16_t*)(ws + WS_WB);
  bf16_t* N1 = (bf16_t*)(ws + WS_N1); bf16_t* N2 = (bf16_t*)(ws + WS_N2); bf16_t* VF = (bf16_t*)(ws + WS_VF);
  bf16_t* R = (bf16_t*)(ws + WS_R);
  if (ph == 0) {
    for (int job = blockIdx.x; job < 288; job += gridDim.x) mod_job(p, job, (float*)smem, wave_s);
    rope_table(p, wave_s);
    conv_layer(p, 0, smem, wave_s);
    return true;
  }
  if (ph == 1) {
    RowPass a{}; a.xl = p.in[0]; a.xc = p.in[2]; a.ol = nullptr; a.oc = nullptr; a.y = nullptr;
    a.n = N1; a.gpre = p.in[6]; a.modn = MOD; a.mshift = 0; a.mscale = 1; a.tmax = T;
    rowpass(a, wave_s); return true;
  }
  const int i = (ph - 2) / 12, s = (ph - 2) % 12, kind = i % 3, j = i / 3;
  const float* ng = p.in[6] + (size_t)i * 6 * 1024;
  const float* modi = MOD + (size_t)i * 9 * 9216;
  int gsel = -1;
  GemmArgs g{}; g.M = T;
  const bool noctx = (i == 3 && s >= 6);
  if (noctx) g.M = TL;
  bf16_t* SLAB = R + (size_t)T * FF;
  EpiBf16 eb{}; EpiSwiglu es{}; EpiFeat ef{}; EpiReadout er0{}, er1{};
  GemmArgs g2{};
  switch (s) {
    case 0: case 9: { const int h = s == 9; g.A1 = N1; g.A2 = N1; g.ksplit = 1024; g.lda = 1024; g.Bt = WB + (h ? WB_UP1 : WB_UP0); g.N = 5632; g.K = 1024; es.H = R; gsel = 0; break; }
    case 1: case 10: { const int h = s == 10; g.A1 = R; g.A2 = R; g.ksplit = FF; g.lda = FF; g.Bt = WB + (h ? WB_DN1 : WB_DN0); g.N = 1024; g.K = FF; eb.O = N2; eb.ldc = 1024; eb.slab = SLAB; g.split = noctx ? 0 : 3; gsel = 1; break; }
    case 2: case 8: case 11: {
      RowPass a{};
      const bool first = (i == 0 && s == 2);
      a.xl = first ? p.in[0] : p.out; a.xc = first ? p.in[2] : XC; a.ol = p.out; a.oc = XC;
      a.y = N2; a.modg = modi; a.tmax = noctx ? TL : T; a.yslab = SLAB; a.nslab = (s == 8) ? 2 : 3;
      if (s == 2) { a.gpost = ng + 1024; a.mgate = 2; a.coef = 0.5f; a.n = N1; a.gpre = ng + 2 * 1024; a.modn = modi; a.mshift = 3; a.mscale = 4; }
      else if (s == 8) { a.gpost = ng + 3 * 1024; a.mgate = 5; a.coef = 1.f; a.n = N1; a.gpre = ng + 4 * 1024; a.modn = modi; a.mshift = 6; a.mscale = 7; }
      else { a.gpost = ng + 5 * 1024; a.mgate = 8; a.coef = 0.5f;
        if (i < 3) { a.n = N1; a.gpre = ng + 6 * 1024; a.modn = modi + 9 * 9216; a.mshift = 0; a.mscale = 1; }
        else { a.n = nullptr; a.tmax = TL; } }
      rowpass(a, wave_s);
      if (s == 11 && i < 3) conv_layer(p, i + 1, smem, wave_s);
      return true;
    }
    case 3:
      if (kind == 0) { shift_phase(N1, N2, wave_s); return true; }
      g.A1 = N1; g.A2 = N1; g.ksplit = 1024; g.lda = 1024; g.Bt = WB + WB_MIX; g.N = 1536; g.K = 1024; eb.O = R; eb.ldc = 1536; gsel = 1; break;
    case 4:
      if (kind == 0) { g.A1 = N1; g.A2 = N2; g.ksplit = 1024; g.lda = 1024; g.Bt = WB + WB_MIX; g.N = 3840; g.K = 2048; ef.Fr = R; ef.Fl = R + R_FL; ef.VF = VF; ef.dup_v = (j == 0); gsel = 2; break; }
      attn_post(p, kind == 1 ? 0 : 1, smem, wave_s); return true;
    case 5:
      if (kind == 0) scan_phase(p, j, smem, wave_s); else attn_core(p, kind == 1 ? 0 : 1, smem, wave_s);
      return true;
    case 6:
      if (kind != 0) return false;
      g.A1 = R + R_FL + 256; g.A2 = g.A1; g.ksplit = 256; g.lda = 768; g.Bt = WB + WB_G2T; g.N = 1024; g.K = 256;
      g2 = g; g2.A1 = R + R_FL + 512; g2.A2 = g2.A1; g2.Bt = WB + WB_G2T + (size_t)1024 * 256;
      er0.O = R; er0.Z = N1; er0.add = 0; er1.O = R; er1.Z = N2; er1.add = 1; gsel = 3; break;
    case 7:
      g.A1 = R; g.A2 = R; g.ksplit = 1024; g.lda = 1024; g.Bt = WB + WB_WO; g.N = 1024; g.K = 1024; eb.O = N2; eb.ldc = 1024; eb.slab = SLAB; g.split = noctx ? 0 : 2; gsel = 1; break;
  }
  if (gsel == 0) gemm_phase(g, es, smem, wave_s);
  else if (gsel == 1) gemm_phase(g, eb, smem, wave_s);
  else if (gsel == 2) gemm_phase(g, ef, smem, wave_s);
  else if (gsel == 3) { gemm_phase(g, er0, smem, wave_s); gemm_phase(g2, er1, smem, wave_s); }
  return true;
}


#define XB_TMO      128
#define XB_XCNT(j)  (256  + 64 * (j))
#define XB_XSUB(j)  (1280 + 64 * (j))
#define XB_XGEN(j)  (2304 + 64 * (j))
#define XB_TOP      3328
#define XB_TOPGEN   3392
#define XCD_BAR_WORDS 3456
#define XB_SPIN_CAP (1u << 22)
#define LAS __attribute__((address_space(3)))
DEVI unsigned xb_ld(unsigned* p)              { return __hip_atomic_load(p, __ATOMIC_RELAXED, __HIP_MEMORY_SCOPE_AGENT); }
DEVI unsigned xb_add(unsigned* p, unsigned v) { return __hip_atomic_fetch_add(p, v, __ATOMIC_RELAXED, __HIP_MEMORY_SCOPE_AGENT); }
DEVI unsigned xb_xcc_id() { return (unsigned)__builtin_amdgcn_s_getreg((3 << 11) | 20) & 0xFu; }
#define XB_SPIN(cond, bar) do { unsigned _sp = 0; while (cond) { __builtin_amdgcn_s_sleep(1); \
    if ((++_sp & 255u) == 0u) { if (xb_ld(&(bar)[XB_TMO])) break; if (_sp > XB_SPIN_CAP) { atomicAdd(&(bar)[XB_TMO], 1u); break; } } } } while (0)
struct XcdBarrier { unsigned* bar; unsigned x; volatile LAS unsigned* st; };
DEVI void xcd_barrier_complete(unsigned* bar, unsigned x, unsigned& nloc, unsigned& nx) {
  const unsigned G = gridDim.x;
  unsigned sum, cnt, mine, sp = 0u;
  for (;;) {
    sum = 0u; cnt = 0u; mine = 0u;
#pragma unroll
    for (unsigned j = 0; j < 16; ++j) { const unsigned c = xb_ld(&bar[XB_XCNT(j)]); sum += c; cnt += (c > 0u) ? 1u : 0u; mine = (j == x) ? c : mine; }
    if (sum == G) break;
    __builtin_amdgcn_s_sleep(1);
    if ((++sp & 255u) == 0u) { if (xb_ld(&bar[XB_TMO])) break; if (sp > XB_SPIN_CAP) { atomicAdd(&bar[XB_TMO], 1u); break; } }
  }
  nloc = mine > 0u ? mine : 1u; nx = cnt > 0u ? cnt : 1u;
}
DEVI void xcd_barrier(const XcdBarrier& b, bool t0) {
  asm volatile("s_waitcnt vmcnt(0)" ::: "memory");
  __syncthreads();
  if (t0) {
    unsigned* bar = b.bar;
    __builtin_amdgcn_s_waitcnt(0);
    unsigned nloc = b.st[0], nx = b.st[1];
    if (nloc == 0u) { xcd_barrier_complete(bar, b.x, nloc, nx); b.st[0] = nloc; b.st[1] = nx; }
    const unsigned old = xb_add(&bar[XB_XSUB(b.x)], 1u);
    const unsigned gen = old / nloc;
    if (old + 1u == (gen + 1u) * nloc) {
      __builtin_amdgcn_fence(__ATOMIC_RELEASE, "agent");
      asm volatile("s_waitcnt vmcnt(0)" ::: "memory");
      const unsigned og = xb_add(&bar[XB_TOP], 1u);
      const unsigned tg = og / nx;
      if (og + 1u == (tg + 1u) * nx) xb_add(&bar[XB_TOPGEN], 1u);
      else XB_SPIN(xb_ld(&bar[XB_TOPGEN]) == tg, bar);
      __builtin_amdgcn_fence(__ATOMIC_ACQUIRE, "agent");
      xb_add(&bar[XB_XGEN(b.x)], 1u);
      asm volatile("s_waitcnt vmcnt(0)" ::: "memory");
    } else {
      XB_SPIN(xb_ld(&bar[XB_XGEN(b.x)]) == gen, bar);
      __builtin_amdgcn_fence(__ATOMIC_ACQUIRE, "agent");
      asm volatile("s_waitcnt vmcnt(0)" ::: "memory");
    }
  }
  __syncthreads();
}

constexpr int LDS_BYTES = 155648;
constexpr size_t WS_BAR = 3 * MiB / 2;
__global__ void __launch_bounds__(NT) mega(Params p) {
  extern __shared__ __attribute__((aligned(16))) unsigned char smem[];
  cg::grid_group grid = cg::this_grid();
  const int wave_s = __builtin_amdgcn_readfirstlane((int)(threadIdx.x >> 6));
  const int ph_lo = p.ph_lo, ph_hi = p.ph_hi;
  __shared__ uint4 xb_words;
  XcdBarrier xb; xb.bar = (unsigned*)(p.ws + WS_BAR); xb.x = xb_xcc_id(); xb.st = (volatile LAS unsigned*)&xb_words;
  if (ph_hi - ph_lo > 1) {
    const bool t0 = opaque_tid(wave_s) == 0;
    if (t0) { xb_words = make_uint4(0u, 0u, 0u, 0u); (void)xb_add(&xb.bar[XB_XCNT(xb.x)], 1u); }
    __syncthreads();
  }
  for (int ph = ph_lo; ph < ph_hi; ++ph) {
    KParams* pp = (KParams*)__builtin_amdgcn_kernarg_segment_ptr();
    asm volatile("" : "+s"(pp));
    const bool ran = run_phase(*pp, ph, smem, wave_s);
    if (ran && ph + 1 < ph_hi) {
      if (ph == ph_lo) grid.sync();
      else xcd_barrier(xb, opaque_tid(wave_s) == 0);
    }
  }
}

extern "C" void kernel_launch(void* const* d_in, const int* in_sizes, int n_in, void* d_out, int out_size, void* d_ws, size_t ws_size, hipStream_t stream) {
  static int grid_blocks = 0;
  if (!grid_blocks) {
    int dev = 0, cus = 0, per_cu = 0;
    hipGetDevice(&dev);
    hipDeviceGetAttribute(&cus, hipDeviceAttributeMultiprocessorCount, dev);
    hipFuncSetAttribute((const void*)mega, hipFuncAttributeMaxDynamicSharedMemorySize, LDS_BYTES);
    hipOccupancyMaxActiveBlocksPerMultiprocessor(&per_cu, (const void*)mega, NT, LDS_BYTES);
    if (per_cu < 1) per_cu = 1;
    if (per_cu > 1) per_cu = 1;
    grid_blocks = cus * per_cu;
    if (ws_size < WS_END || n_in != 42) fprintf(stderr, "kernel_launch: unexpected ws_size %zu / n_in %d\n", ws_size, n_in);
  }
  Params p{};
  for (int i = 0; i < 42; ++i) p.in[i] = (const float*)d_in[i];
  p.out = (float*)d_out; p.ws = (unsigned char*)d_ws;
  const int NPH = 2 + 4 * 12;
#if ONE_LAUNCH
  if (hipMemsetAsync((char*)d_ws + WS_BAR, 0, XCD_BAR_WORDS * sizeof(unsigned), stream) != hipSuccess) fprintf(stderr, "memset of barrier words failed\n");
  p.ph_lo = 0; p.ph_hi = NPH;
  void* args[] = {&p};
  hipError_t e = hipLaunchCooperativeKernel((const void*)mega, dim3(grid_blocks), dim3(NT), args, LDS_BYTES, stream);
  if (e != hipSuccess) fprintf(stderr, "cooperative launch failed: %s (grid %d)\n", hipGetErrorString(e), grid_blocks);
#else
  for (int ph = 0; ph < NPH; ++ph) {
    p.ph_lo = ph; p.ph_hi = ph + 1;
    hipLaunchKernelGGL(mega, dim3(grid_blocks), dim3(NT), LDS_BYTES, stream, p);
  }
#endif
}
```
